# Optimizing an MI355X kernel written in HIP

```python
import math
import jax, jax.numpy as jnp
from jax import lax
import numpy as np


D_MODEL = 1024
BATCH = 8
SEQ = 2048
DEPTH = 2
DEC_BATCH = 128
DEC_SEQ = 4
PAST_LEN = 16384
PAGE_SIZE = 128

N_HEADS_A = 8
N_KV_A = 2
HEAD_DIM = 64
GQA_GROUP = N_HEADS_A // N_KV_A
WINDOW = 128
ATTN_WIDTH = N_HEADS_A * HEAD_DIM
KV_WIDTH = N_KV_A * HEAD_DIM
N_BUCKETS = 32
MAX_DISTANCE = 128
POOL_WINDOWS = (2, 4, 8, 16)
N_POOL_GROUPS = len(POOL_WINDOWS)
POOL_GROUP = 128
POOL_WIDTH = N_POOL_GROUPS * POOL_GROUP
POOL_BUF = max(POOL_WINDOWS) - 1
IN_EVEN = ATTN_WIDTH + 2 * KV_WIDTH + POOL_WIDTH
CHUNK = 128
SGU_WIDTH = 1024
SGU_GROUPS = 4
SGU_GROUP_W = SGU_WIDTH // SGU_GROUPS
D_FF = 2816
N_EVEN = (DEPTH + 1) // 2
N_ODD = DEPTH // 2
EPS = 1e-6
NEG = -1e30

kernel_name = 'hybrid_swa_pool_sgu_macaron_step'


def rmsnorm(x, g):
    xf = x.astype(jnp.float32)
    y = xf * lax.rsqrt(jnp.mean(xf * xf, axis=-1, keepdims=True) + EPS)
    return (y * g.astype(jnp.float32)).astype(x.dtype)


def macaron_half(x, g, wg, wu, wd):
    h = rmsnorm(x, g)
    return x + 0.5 * ((jax.nn.silu(h @ wg) * (h @ wu)) @ wd)


def t5_bucket(dist):
    n = jnp.maximum(dist, 0)
    max_exact = N_BUCKETS // 2
    nf = jnp.maximum(n, 1).astype(jnp.float32)
    large = max_exact + (jnp.log(nf / max_exact) / math.log(MAX_DISTANCE / max_exact)
                         * (N_BUCKETS - max_exact)).astype(jnp.int32)
    large = jnp.minimum(large, N_BUCKETS - 1)
    return jnp.where(n < max_exact, n, large)


def band_attention(q, k, v, dist, valid, sink, rel_bias):
    B, N, Q = q.shape[:3]
    S = k.shape[2]
    qg = q.reshape(B, N, Q, N_KV_A, GQA_GROUP, HEAD_DIM)
    logits = jnp.einsum('bnqkgd,bnskd->bnkgqs', qg, k).astype(jnp.float32) * (HEAD_DIM ** -0.5)
    bias = rel_bias[t5_bucket(dist)].astype(jnp.float32)
    bias = bias.transpose(2, 0, 1).reshape(N_KV_A, GQA_GROUP, Q, S)
    logits = jnp.where(valid[None, :, None, None], logits + bias, NEG)
    s = sink.astype(jnp.float32).reshape(N_KV_A, GQA_GROUP, 1, 1)
    m = jnp.maximum(jnp.max(logits, axis=-1, keepdims=True), s)
    p = jnp.exp(logits - m)
    p = p / (jnp.sum(p, axis=-1, keepdims=True) + jnp.exp(s - m))
    out = jnp.einsum('bnkgqs,bnskd->bnqkgd', p.astype(v.dtype), v)
    return out.reshape(B, N, Q, ATTN_WIDTH)


def attn_prompt(q, k, v, sink, rel_bias):
    B, S = q.shape[:2]
    nb = S // WINDOW
    qb = q.reshape(B, nb, WINDOW, N_HEADS_A, HEAD_DIM)

    def band(t):
        tp = jnp.concatenate([jnp.zeros_like(t[:, :WINDOW]), t], axis=1)
        tp = tp.reshape(B, nb + 1, WINDOW, N_KV_A, HEAD_DIM)
        return jnp.concatenate([tp[:, :-1], tp[:, 1:]], axis=2)

    kb, vb = band(k), band(v)
    qi = jnp.arange(WINDOW)[:, None] + WINDOW
    kj = jnp.arange(2 * WINDOW)[None, :]
    dist = qi - kj
    blk = jnp.arange(nb)[:, None, None]
    valid = (dist >= 0) & (dist < WINDOW) & (blk * WINDOW + kj - WINDOW >= 0)
    out = band_attention(qb, kb, vb, dist, valid, sink, rel_bias)
    return out.reshape(B, S, ATTN_WIDTH)


def attn_sample(q, k, v, buf_k, buf_v, sink, rel_bias):
    B, T = q.shape[:2]
    kk = jnp.concatenate([buf_k.astype(k.dtype), k], axis=1)
    vv = jnp.concatenate([buf_v.astype(v.dtype), v], axis=1)
    dist = (WINDOW + jnp.arange(T))[:, None] - jnp.arange(WINDOW + T)[None, :]
    valid = ((dist >= 0) & (dist < WINDOW))[None]
    out = band_attention(q[:, None], kk[:, None], vv[:, None], dist, valid, sink, rel_bias)
    return out.reshape(B, T, ATTN_WIDTH), kk[:, -WINDOW:], vv[:, -WINDOW:]


def pool_mix(u, ctx, pos0, w_pool, scale):
    B, T = u.shape[:2]
    z = jnp.concatenate([ctx.astype(u.dtype), u], axis=1)
    zf = z.astype(jnp.float32)
    cs = jnp.concatenate([jnp.zeros_like(zf[:, :1]), jnp.cumsum(zf, axis=1)], axis=1)
    end = cs[:, POOL_BUF + 1:]
    pos = pos0 + jnp.arange(T)
    means = []
    for g, w in enumerate(POOL_WINDOWS):
        sl = slice(g * POOL_GROUP, (g + 1) * POOL_GROUP)
        start = cs[:, POOL_BUF + 1 - w: POOL_BUF + 1 - w + T, sl]
        cnt = jnp.minimum(pos + 1, w).astype(jnp.float32)[None, :, None]
        means.append((end[..., sl] - start) / cnt)
    d = jnp.concatenate(means, axis=-1) - zf[:, POOL_BUF:]
    d = d.astype(u.dtype).reshape(B, T, N_POOL_GROUPS, POOL_GROUP)
    y = jnp.einsum('btgc,gcd->btgd', d, w_pool).reshape(B, T, POOL_WIDTH)
    return y * scale, z[:, -POOL_BUF:]


def even_mixer(h, prompt, buf_k, buf_v, buf_pool, w_in, w_out, sink, rel_bias, w_pool, pool_scale):
    B, T = h.shape[:2]
    proj = h @ w_in
    q, k, v, up = jnp.split(proj, [ATTN_WIDTH, ATTN_WIDTH + KV_WIDTH, ATTN_WIDTH + 2 * KV_WIDTH], axis=-1)
    q = q.reshape(B, T, N_HEADS_A, HEAD_DIM)
    k = k.reshape(B, T, N_KV_A, HEAD_DIM)
    v = v.reshape(B, T, N_KV_A, HEAD_DIM)
    if prompt:
        a = attn_prompt(q, k, v, sink, rel_bias)
        nk, nv = k[:, -WINDOW:], v[:, -WINDOW:]
        p, npool = pool_mix(up, jnp.zeros((B, POOL_BUF, POOL_WIDTH), up.dtype), 0, w_pool, pool_scale)
    else:
        a, nk, nv = attn_sample(q, k, v, buf_k, buf_v, sink, rel_bias)
        p, npool = pool_mix(up, buf_pool, PAST_LEN, w_pool, pool_scale)
    y = jnp.concatenate([a, p], axis=-1) @ w_out
    return y, nk, nv, npool


def odd_mixer(h, w_in, g_v, w_s, b_s, w_out):
    B, T = h.shape[:2]
    uv = jax.nn.gelu(h @ w_in)
    u, v = jnp.split(uv, 2, axis=-1)
    v = rmsnorm(v, g_v)
    L = min(T, CHUNK)
    nc = T // L
    vc = v.reshape(B, nc, L, SGU_GROUPS, SGU_GROUP_W)
    w = jnp.tril(w_s[:, :L, :L])
    mixed = jnp.einsum('gts,bnsgc->bntgc', w, vc) + b_s[:, :L].T[:, :, None]
    y = (u * mixed.reshape(B, T, SGU_WIDTH)) @ w_out
    return y, v


def setup_inputs(seed: int = 0) -> dict:
    key = jax.random.key(seed)
    ks = jax.random.split(key, 21)

    def nrm(k, shape, s):
        return jax.random.normal(k, shape, jnp.float32) * s

    return {
        'x_prompt': nrm(ks[0], (BATCH, SEQ, D_MODEL), 1.0),
        'x_sample': nrm(ks[1], (DEC_BATCH, DEC_SEQ, D_MODEL), 1.0),
        'state_win_k': nrm(ks[2], (N_EVEN, DEC_BATCH, WINDOW, N_KV_A, HEAD_DIM), 1.0),
        'state_win_v': nrm(ks[3], (N_EVEN, DEC_BATCH, WINDOW, N_KV_A, HEAD_DIM), 1.0),
        'state_pool': nrm(ks[4], (N_EVEN, DEC_BATCH, POOL_BUF, POOL_WIDTH), 1.0),
        'rel_bias': nrm(ks[5], (N_BUCKETS, N_HEADS_A), 0.5),
        'norm_gains': 1.0 + nrm(ks[6], (DEPTH, 3, D_MODEL), 0.05),
        'final_gain': 1.0 + nrm(ks[7], (D_MODEL,), 0.05),
        'ffn_gate': nrm(ks[8], (DEPTH, 2, D_MODEL, D_FF), D_MODEL ** -0.5),
        'ffn_up': nrm(ks[9], (DEPTH, 2, D_MODEL, D_FF), D_MODEL ** -0.5),
        'ffn_down': nrm(ks[10], (DEPTH, 2, D_FF, D_MODEL), D_FF ** -0.5),
        'w_in_even': nrm(ks[11], (N_EVEN, D_MODEL, IN_EVEN), D_MODEL ** -0.5),
        'w_out_even': nrm(ks[12], (N_EVEN, ATTN_WIDTH + POOL_WIDTH, D_MODEL), (ATTN_WIDTH + POOL_WIDTH) ** -0.5),
        'attn_sinks': nrm(ks[13], (N_EVEN, N_HEADS_A), 1.0),
        'w_pool': nrm(ks[14], (N_EVEN, N_POOL_GROUPS, POOL_GROUP, POOL_GROUP), POOL_GROUP ** -0.5),
        'pool_scale': 1.0 + nrm(ks[15], (N_EVEN, POOL_WIDTH), 0.1),
        'w_in_odd': nrm(ks[16], (N_ODD, D_MODEL, 2 * SGU_WIDTH), D_MODEL ** -0.5),
        'sgu_norm': 1.0 + nrm(ks[17], (N_ODD, SGU_WIDTH), 0.05),
        'w_spatial': nrm(ks[18], (N_ODD, SGU_GROUPS, CHUNK, CHUNK), CHUNK ** -0.5),
        'b_spatial': 1.0 + nrm(ks[19], (N_ODD, SGU_GROUPS, CHUNK), 0.1),
        'w_out_odd': nrm(ks[20], (N_ODD, SGU_WIDTH, D_MODEL), SGU_WIDTH ** -0.5),
    }


def reference(x_prompt, x_sample, state_win_k, state_win_v, state_pool, rel_bias, norm_gains, final_gain,
              ffn_gate, ffn_up, ffn_down, w_in_even, w_out_even, attn_sinks, w_pool, pool_scale,
              w_in_odd, sgu_norm, w_spatial, b_spatial, w_out_odd):
    xp, xs = x_prompt, x_sample
    kp_l, vp_l, pp_l, ks_l, vs_l, ps_l, sv_l = [], [], [], [], [], [], []
    for l in range(DEPTH):
        fa = (norm_gains[l, 0], ffn_gate[l, 0], ffn_up[l, 0], ffn_down[l, 0])
        fb = (norm_gains[l, 2], ffn_gate[l, 1], ffn_up[l, 1], ffn_down[l, 1])
        xp, xs = macaron_half(xp, *fa), macaron_half(xs, *fa)
        hp, hs = rmsnorm(xp, norm_gains[l, 1]), rmsnorm(xs, norm_gains[l, 1])
        if l % 2 == 0:
            e = l // 2
            wts = (w_in_even[e], w_out_even[e], attn_sinks[e], rel_bias, w_pool[e], pool_scale[e])
            yp, kp, vp, pp = even_mixer(hp, True, None, None, None, *wts)
            ys, k_s, v_s, p_s = even_mixer(hs, False, state_win_k[e], state_win_v[e], state_pool[e], *wts)
            kp_l.append(kp); vp_l.append(vp); pp_l.append(pp)
            ks_l.append(k_s); vs_l.append(v_s); ps_l.append(p_s)
        else:
            o = l // 2
            wts = (w_in_odd[o], sgu_norm[o], w_spatial[o], b_spatial[o], w_out_odd[o])
            yp, _ = odd_mixer(hp, *wts)
            ys, sv = odd_mixer(hs, *wts)
            sv_l.append(sv)
        xp, xs = xp + yp, xs + ys
        xp, xs = macaron_half(xp, *fb), macaron_half(xs, *fb)
    y_prompt = rmsnorm(xp, final_gain)
    y_sample = rmsnorm(xs, final_gain)
    new_win_k_prompt = jnp.stack(kp_l)
    new_win_v_prompt = jnp.stack(vp_l)
    new_pool_prompt = jnp.stack(pp_l)
    new_win_k_sample = jnp.stack(ks_l)
    new_win_v_sample = jnp.stack(vs_l)
    new_pool_sample = jnp.stack(ps_l)
    new_sgu_v_sample = jnp.stack(sv_l)
    return (y_prompt, y_sample, new_win_k_prompt, new_win_v_prompt, new_pool_prompt,
            new_win_k_sample, new_win_v_sample, new_pool_sample, new_sgu_v_sample)
```

```cpp
#include <hip/hip_runtime.h>
#include <cstdio>
#include <cstdint>

#define LAS __attribute__((address_space(3)))
#define GAS __attribute__((address_space(1)))
#define DI __device__ __forceinline__
typedef unsigned short bf16_t;
typedef short bf16x8 __attribute__((ext_vector_type(8)));
typedef float f32x4 __attribute__((ext_vector_type(4)));
typedef float f32x2 __attribute__((ext_vector_type(2)));
typedef float f32x16 __attribute__((ext_vector_type(16)));
typedef unsigned u32x4 __attribute__((ext_vector_type(4)));
typedef unsigned u32x2 __attribute__((ext_vector_type(2)));
typedef __bf16 bf16x2_t __attribute__((ext_vector_type(2)));

#ifndef PHM
#define PHM 0xffff
#endif
#ifndef MK_PER_PHASE
#define MK_PER_PHASE 0
#endif

constexpr int DM = 1024, NBATCH = 8, SEQ = 2048, DBATCH = 128, DSEQ = 4;
constexpr int MP = NBATCH * SEQ, MS = DBATCH * DSEQ, MROWS = MP + MS;
constexpr int FF = 2816, NGU = 2 * FF, NIN0 = 1280, NIN1 = 2048;
constexpr float EPS = 1e-6f, NEGV = -1e30f, LOG2E = 1.4426950408889634f;

constexpr size_t WS_CTL = 0, CTL_BYTES = 1u << 20;
constexpr size_t SZ_WGU = (size_t)NGU * DM * 2, SZ_WD = (size_t)DM * FF * 2;
constexpr size_t WS_WGU = CTL_BYTES;
constexpr size_t WS_WD = WS_WGU + 4 * SZ_WGU;
constexpr size_t WS_WIN0 = WS_WD + 4 * SZ_WD;
constexpr size_t WS_WOUT0 = WS_WIN0 + (size_t)NIN0 * DM * 2;
constexpr size_t WS_WIN1 = WS_WOUT0 + (size_t)DM * DM * 2;
constexpr size_t WS_WOUT1 = WS_WIN1 + (size_t)NIN1 * DM * 2;
constexpr size_t WS_WPT = WS_WOUT1 + (size_t)DM * DM * 2;
constexpr size_t WS_WST = WS_WPT + 4 * 128 * 128 * 2;
constexpr size_t WS_BIAS = WS_WST + 4 * 128 * 128 * 2;
constexpr size_t SZ_SSP = (size_t)16 * MROWS * 4;
constexpr size_t WS_SSP = WS_BIAS + 8 * 128 * 4;
constexpr size_t WS_XB = WS_SSP + 8 * SZ_SSP;
constexpr size_t WS_ACT = WS_XB + (size_t)MROWS * DM * 2;
constexpr size_t WS_END = WS_ACT + (size_t)MROWS * FF * 2;
constexpr size_t WS_Q = WS_ACT, WS_K = WS_Q + (size_t)MROWS * 512 * 2, WS_V = WS_K + (size_t)MROWS * 128 * 2, WS_UP = WS_V + (size_t)MROWS * 128 * 2, WS_CAT = WS_UP + (size_t)MROWS * 512 * 2;
constexpr size_t WS_U = WS_ACT, WS_V1 = WS_U + (size_t)MROWS * 1024 * 2;
static_assert(WS_CAT + (size_t)MROWS * 1024 * 2 <= WS_END && WS_V1 + (size_t)MROWS * 1024 * 2 <= WS_END && WS_END <= 268435456, "d_ws map");

constexpr size_t O_Y = 0, O_KP = (size_t)MROWS * DM, O_VP = O_KP + 8 * 128 * 128, O_PP = O_VP + 8 * 128 * 128, O_KS = O_PP + 8 * 15 * 512,
                 O_VS = O_KS + (size_t)128 * 128 * 128, O_PS = O_VS + (size_t)128 * 128 * 128, O_SV = O_PS + (size_t)128 * 15 * 512, O_END = O_SV + (size_t)128 * 4 * 1024;

constexpr int CW_BAR = 4096, CW_FIN = 7680;
constexpr int GRID = 256;
constexpr int RING_BYTES = 131072, MISC_OFF = RING_BYTES, RS_OFF = RING_BYTES + 1024, LDS_BYTES = 147456;

DI unsigned pk2(float lo, float hi) { f32x2 v = {lo, hi}; bf16x2_t b = __builtin_convertvector(v, bf16x2_t); return __builtin_bit_cast(unsigned, b); }
DI float bflo(unsigned w) { return __uint_as_float(w << 16); }
DI float bfhi(unsigned w) { return __uint_as_float(w & 0xffff0000u); }
DI float bf2f(bf16_t b) { return __uint_as_float((unsigned)b << 16); }
DI bf16_t f2bf(float f) { return (bf16_t)(pk2(f, 0.f) & 0xffffu); }
DI void st4_wt(float* p, float v) { asm volatile("global_store_dword %0, %1, off sc1\n\ts_nop 1" :: "v"(p), "v"(v) : "memory"); }
DI void wait_count(unsigned* c, unsigned need) {
    for (unsigned sp = 0; __hip_atomic_load(c, __ATOMIC_RELAXED, __HIP_MEMORY_SCOPE_AGENT) < need && sp < (1u << 18); ++sp) __builtin_amdgcn_s_sleep(2);
    __builtin_amdgcn_fence(__ATOMIC_ACQUIRE, "agent");
    asm volatile("s_waitcnt vmcnt(0)" ::: "memory");
}
DI float fexp(float x) { return __builtin_amdgcn_exp2f(x * LOG2E); }
DI float wave_sum(float v) {
#pragma unroll
    for (int o = 1; o < 64; o <<= 1) v += __shfl_xor(v, o);
    return v;
}

namespace pg8 {
constexpr int BM = 256, BK = 64, HALF = 128, HTB = HALF * BK * 2, STAGE_BYTES = 8 * HTB, NXCD = 8, WGM = 8;
__host__ __device__ __forceinline__ int lds_byte(int r, int c) { const int st = (r >> 4) * 2 + (c >> 5), rr = r & 15, cc = c & 31, ob = rr * 64 + cc * 2; return st * 1024 + (ob ^ (((ob >> 9) & 1) << 5)); }
__host__ __device__ __forceinline__ void stage_rc(int b, int& R, int& C) { const int st = b / 1024, sb = b % 1024, swz = sb ^ (((sb >> 9) & 1) << 5); R = (st >> 1) * 16 + swz / 64; C = (st & 1) * 32 + (swz % 64) / 2; }
__host__ __device__ __forceinline__ int perm32(int rho) { const int n = rho >> 4, i = rho & 15; return 8 * (i >> 2) + 4 * n + (i & 3); }

struct Unit { int pm, pn; };
struct Gemm { const bf16_t* A; const bf16_t* Bt; int M, N, K; };

struct Order {
    int nM, nN, nwg, G, c;
    const float* ssp; LAS float* rs;
    DI void init(int M, int N, int G_, int c_) { nM = M / BM; nN = N / BM; nwg = nM * nN; G = G_; c = c_; }
    DI bool next(int i, Unit& u) const {
        const long L = (long)i * G + c; if (L >= nwg) return false;
        int wgid = (int)L; { const int q = nwg / NXCD, r = nwg % NXCD, xcd = wgid % NXCD, off = wgid / NXCD; wgid = (xcd < r ? xcd * (q + 1) : r * (q + 1) + (xcd - r) * q) + off; }
        const int nig = WGM * nN, gid = wgid / nig, fm = gid * WGM, gsz = (nM - fm) < WGM ? (nM - fm) : WGM;
        u.pm = fm + ((wgid % nig) % gsz); u.pn = (wgid % nig) / gsz; return true;
    }
    DI void rs_all(int tid) const {
        if (ssp) { const int row = tid >> 1, half = tid & 1; float s[6];
            float pv[6][8];
#pragma unroll
            for (int i = 0; i < 6; ++i) { Unit u; if (!next(i, u)) next(0, u); const float* p = ssp + (size_t)(8 * half) * MROWS + u.pm * BM + row;
#pragma unroll
                for (int k = 0; k < 8; ++k) pv[i][k] = p[(size_t)k * MROWS]; }
#pragma unroll
            for (int i = 0; i < 6; ++i) s[i] = ((pv[i][0] + pv[i][1]) + (pv[i][2] + pv[i][3])) + ((pv[i][4] + pv[i][5]) + (pv[i][6] + pv[i][7]));
#pragma unroll
            for (int i = 0; i < 6; ++i) { float t = s[i]; t += __shfl_xor(t, 1); if (!half) rs[i * 256 + row] = rsqrtf(t * (1.0f / DM) + EPS); } }
    }
    DI void a_ready(const Unit& u, int slot, int tid) const {
        if (ssp) {
            const int row = tid >> 1, half = tid & 1;
            const float* p = ssp + (size_t)(8 * half) * MROWS + u.pm * BM + row;
            float s = 0.f;
#pragma unroll
            for (int k = 0; k < 8; ++k) s += p[(size_t)k * MROWS];
            s += __shfl_xor(s, 1);
            if (!half) rs[slot * 256 + row] = rsqrtf(s * (1.0f / DM) + EPS);
        }
    }
};

constexpr int STRIP_OFF = RS_OFF + 6 * 1024;
static_assert(STRIP_OFF + 8192 <= LDS_BYTES && STRIP_OFF % 16 == 0, "strip ring LDS map");
template <class Epi, class Sched, bool ALIGN_EPI, bool SP2, bool STRIP = false>
DI void gemm_phase(LAS unsigned char* lds, const Gemm g, const Sched& S, const Epi& E, const int tid) {
    const int wid = __builtin_amdgcn_readfirstlane(tid >> 6), lane = tid & 63, wr = wid >> 2, wc = wid & 3, fr = lane & 15, fq = lane >> 4;
    const int K = g.K, nt = K / BK;
    unsigned voffA[2], voffB[2];
#pragma unroll
    for (int i = 0; i < 2; ++i) { int R, C; stage_rc(tid * 16 + i * 8192, R, C); const int Rb = (R & ~31) + perm32(R & 31);
        voffA[i] = (unsigned)(R * K + C) * 2u; voffB[i] = (unsigned)(Rb * K + C) * 2u; }
    const size_t kstep = (size_t)(BK * 2);
    const size_t hstep = (size_t)HALF * K * 2;
    const size_t tstep = 2 * hstep;
    const unsigned ldsw = (unsigned)wid * 1024u;
    const int aoff = lds_byte(wr * 64 + fr, fq * 8), boff = lds_byte(wc * 32 + fr, fq * 8) + 4 * HTB;
#define PG8_SA(b, h) (((b) * 2 + (h)) * HTB)
#define PG8_SB(b, h) ((4 + (b) * 2 + (h)) * HTB)
#define PG8_STAGE(bufoff, gbase, voff) do { _Pragma("unroll") for (int _i = 0; _i < 2; ++_i) { \
        asm volatile("s_mov_b32 m0, %1\n\ts_nop 0\n\tglobal_load_lds_dwordx4 %0, %2" \
                     :: "v"((voff)[_i]), "s"((unsigned)(size_t)(lds + (bufoff) + ldsw + _i * 8192)), "s"((const char*)(gbase)) : "memory"); } } while (0)
#define PG8_LDA(dst, b, h) do { _Pragma("unroll") for (int m = 0; m < 4; ++m) _Pragma("unroll") for (int k = 0; k < 2; ++k) dst[m][k] = *(const LAS bf16x8*)(lds + PG8_SA(b, h) + aoff + m * 2048 + k * 1024); } while (0)
#define PG8_LDB(dst, b, h) do { _Pragma("unroll") for (int n = 0; n < 2; ++n) _Pragma("unroll") for (int k = 0; k < 2; ++k) dst[n][k] = *(const LAS bf16x8*)(lds + (PG8_SB(b, h) - 4 * HTB) + boff + n * 2048 + k * 1024); } while (0)
#define PG8_MMA(ai, bj, At, Bt) do { __builtin_amdgcn_s_setprio(1); _Pragma("unroll") for (int m = 0; m < 4; ++m) _Pragma("unroll") for (int n = 0; n < 2; ++n) _Pragma("unroll") for (int k = 0; k < 2; ++k) \
        acc[ai][bj][m][n] = __builtin_amdgcn_mfma_f32_16x16x32_bf16(Bt[n][k], At[m][k], acc[ai][bj][m][n], 0, 0, 0); __builtin_amdgcn_s_setprio(0); } while (0)
#define PG8_WAIT_V(n) asm volatile("s_waitcnt vmcnt(" #n ")" ::: "memory")
#define PG8_WAIT_L(n) asm volatile("s_waitcnt lgkmcnt(" #n ")" ::: "memory")
#define PG8_WAIT_L0 do { __builtin_amdgcn_s_waitcnt(0xC07F); asm volatile("" ::: "memory"); } while (0)
#define PG8_BAR __builtin_amdgcn_s_barrier()
#define PG8_SCHED __builtin_amdgcn_sched_barrier(0)
    Unit cur, nxt; int ui = 0;
    if (!S.next(0, cur)) return;
    f32x4 acc[2][2][4][2];
#pragma unroll
    for (int a = 0; a < 2; ++a)
#pragma unroll
        for (int b = 0; b < 2; ++b)
#pragma unroll
            for (int m = 0; m < 4; ++m)
#pragma unroll
                for (int n = 0; n < 2; ++n) acc[a][b][m][n] = (f32x4){0.f, 0.f, 0.f, 0.f};
    bf16x8 At[4][2], B0[2][2], B1[2][2];
    const char* cA = (const char*)g.A + (size_t)cur.pm * tstep; const char* cB = (const char*)g.Bt + (size_t)cur.pn * tstep;
    f32x4 accS[2] = {{0.f, 0.f, 0.f, 0.f}, {0.f, 0.f, 0.f, 0.f}}; bf16x8 As; int sp = 0; const char* sA = nullptr;
    const int shi = (wid >> 1) & 1;
#define PG8_SSTG(stg, gsrc) asm volatile("s_mov_b32 m0, %1\n\ts_nop 0\n\tglobal_load_lds_dwordx4 %0, %2" :: "v"(voffA[0]), "s"((unsigned)(size_t)(lds + STRIP_OFF + ((stg) + shi) * 2048 + (wid & 1) * 1024)), \
        "s"((gsrc) + (size_t)shi * kstep - (size_t)((wid >> 1) * 16) * K * 2) : "memory")
#define PG8_LDS(stg, k) As = *(const LAS bf16x8*)(lds + STRIP_OFF + (stg) * 2048 + (aoff - wr * 8192) + (k) * 1024)
#define PG8_SMMA(k) do { __builtin_amdgcn_s_setprio(1); if (cur.pm & 1) { _Pragma("unroll") for (int n = 0; n < 2; ++n) accS[n] = __builtin_amdgcn_mfma_f32_16x16x32_bf16(B1[n][k], As, accS[n], 0, 0, 0); } \
        else { _Pragma("unroll") for (int n = 0; n < 2; ++n) accS[n] = __builtin_amdgcn_mfma_f32_16x16x32_bf16(B0[n][k], As, accS[n], 0, 0, 0); } __builtin_amdgcn_s_setprio(0); } while (0)
    if constexpr (STRIP) {
        sA = (const char*)g.A + ((size_t)MP + (size_t)(cur.pm >> 1) * 16) * K * 2;
        PG8_SSTG(0, sA); }
    if constexpr (SP2) {
        PG8_STAGE(PG8_SB(0, 0), cB, voffB); PG8_STAGE(PG8_SB(0, 1), cB + hstep, voffB); PG8_STAGE(PG8_SA(0, 0), cA, voffA); PG8_STAGE(PG8_SA(0, 1), cA + hstep, voffA);
        S.rs_all(tid);
        if (wr == 1) PG8_BAR;
        PG8_WAIT_V(2); PG8_BAR;
        PG8_STAGE(PG8_SB(1, 0), cB + kstep, voffB); PG8_STAGE(PG8_SA(1, 0), cA + kstep, voffA); PG8_STAGE(PG8_SB(1, 1), cB + hstep + kstep, voffB);
        PG8_WAIT_V(6); PG8_BAR;
    } else {
        S.a_ready(cur, 0, tid);
        PG8_STAGE(PG8_SB(0, 0), cB, voffB); PG8_STAGE(PG8_SA(0, 0), cA, voffA); PG8_STAGE(PG8_SB(0, 1), cB + hstep, voffB); PG8_STAGE(PG8_SA(0, 1), cA + hstep, voffA);
        if (wr == 1) PG8_BAR;
        PG8_WAIT_V(4); PG8_BAR;
        PG8_STAGE(PG8_SB(1, 0), cB + kstep, voffB); PG8_STAGE(PG8_SA(1, 0), cA + kstep, voffA); PG8_STAGE(PG8_SB(1, 1), cB + hstep + kstep, voffB);
        PG8_WAIT_V(6); PG8_BAR;
    }
    for (;;) {
        const bool has_next = S.next(ui + 1, nxt);
        const char* nA = has_next ? (const char*)g.A + (size_t)nxt.pm * tstep : cA; const char* nB = has_next ? (const char*)g.Bt + (size_t)nxt.pn * tstep : cB;
        const char* nsA = (STRIP && has_next) ? (const char*)g.A + ((size_t)MP + (size_t)(nxt.pm >> 1) * 16) * K * 2 : sA;
        for (int t = 0; t < nt; t += 2) {
            const bool last = (t == nt - 2);
            const char* a1 = cA + (size_t)(t + 1) * kstep;
            const char* a2 = last ? nA : cA + (size_t)(t + 2) * kstep; const char* b2 = last ? nB : cB + (size_t)(t + 2) * kstep;
            const char* a3 = a2 + kstep; const char* b3 = b2 + kstep;
            if constexpr (SP2 && STRIP) {
            const char* s2 = last ? nsA : sA + (size_t)(t + 2) * kstep;
            PG8_LDB(B0, 0, 0); PG8_LDB(B1, 0, 1); PG8_SCHED; PG8_LDA(At, 0, 0); if (wr == 0) PG8_LDS(2 * sp, 0); PG8_STAGE(PG8_SA(1, 1), a1 + hstep, voffA);
            PG8_WAIT_V(8); PG8_WAIT_L0; PG8_BAR; PG8_MMA(0, 0, At, B0); PG8_MMA(0, 1, At, B1); if (wr == 0) PG8_SMMA(0); PG8_BAR; PG8_SCHED;
            PG8_LDA(At, 0, 1); if (wr == 0) PG8_LDS(2 * sp, 1); PG8_SSTG(2 * (sp ^ 1), s2); PG8_STAGE(PG8_SB(0, 0), b2, voffB); PG8_STAGE(PG8_SB(0, 1), b2 + hstep, voffB); PG8_STAGE(PG8_SA(0, 0), a2, voffA);
            PG8_WAIT_V(9); PG8_WAIT_L0; PG8_BAR; PG8_MMA(1, 0, At, B0); PG8_MMA(1, 1, At, B1); if (wr == 0) PG8_SMMA(1); PG8_BAR; PG8_SCHED;
            PG8_LDB(B0, 1, 0); PG8_LDB(B1, 1, 1); PG8_SCHED; PG8_LDA(At, 1, 0); if (wr == 0) PG8_LDS(2 * sp + 1, 0); PG8_STAGE(PG8_SA(0, 1), a2 + hstep, voffA);
            PG8_WAIT_V(9); PG8_WAIT_L0; PG8_BAR; PG8_MMA(0, 0, At, B0); PG8_MMA(0, 1, At, B1); if (wr == 0) PG8_SMMA(0); PG8_BAR; PG8_SCHED;
            PG8_LDA(At, 1, 1); if (wr == 0) PG8_LDS(2 * sp + 1, 1); PG8_STAGE(PG8_SB(1, 0), b3, voffB); PG8_STAGE(PG8_SB(1, 1), b3 + hstep, voffB); PG8_STAGE(PG8_SA(1, 0), a3, voffA);
            PG8_WAIT_V(8); PG8_WAIT_L0; PG8_BAR; PG8_MMA(1, 0, At, B0); PG8_MMA(1, 1, At, B1); if (wr == 0) PG8_SMMA(1); PG8_BAR; PG8_SCHED;
            sp ^= 1;
            } else if constexpr (SP2) {
            PG8_LDB(B0, 0, 0); PG8_LDB(B1, 0, 1); PG8_SCHED; PG8_LDA(At, 0, 0); PG8_STAGE(PG8_SA(1, 1), a1 + hstep, voffA);
            PG8_WAIT_V(8); PG8_WAIT_L0; PG8_BAR; PG8_MMA(0, 0, At, B0); PG8_MMA(0, 1, At, B1); PG8_BAR; PG8_SCHED;
            PG8_LDA(At, 0, 1); PG8_STAGE(PG8_SB(0, 0), b2, voffB); PG8_STAGE(PG8_SB(0, 1), b2 + hstep, voffB); PG8_STAGE(PG8_SA(0, 0), a2, voffA);
            PG8_WAIT_V(8); PG8_WAIT_L0; PG8_BAR; PG8_MMA(1, 0, At, B0); PG8_MMA(1, 1, At, B1); PG8_BAR; PG8_SCHED;
            PG8_LDB(B0, 1, 0); PG8_LDB(B1, 1, 1); PG8_SCHED; PG8_LDA(At, 1, 0); PG8_STAGE(PG8_SA(0, 1), a2 + hstep, voffA);
            PG8_WAIT_V(8); PG8_WAIT_L0; PG8_BAR; PG8_MMA(0, 0, At, B0); PG8_MMA(0, 1, At, B1); PG8_BAR; PG8_SCHED;
            PG8_LDA(At, 1, 1); PG8_STAGE(PG8_SB(1, 0), b3, voffB); PG8_STAGE(PG8_SB(1, 1), b3 + hstep, voffB); PG8_STAGE(PG8_SA(1, 0), a3, voffA);
            PG8_WAIT_V(8); PG8_WAIT_L0; PG8_BAR; PG8_MMA(1, 0, At, B0); PG8_MMA(1, 1, At, B1); PG8_BAR; PG8_SCHED;
            } else {
            PG8_LDB(B0, 0, 0); PG8_SCHED; PG8_LDA(At, 0, 0); PG8_STAGE(PG8_SA(1, 1), a1 + hstep, voffA);
            PG8_WAIT_L(8); PG8_BAR; PG8_WAIT_L(0); PG8_MMA(0, 0, At, B0); PG8_BAR; PG8_SCHED;
            PG8_LDB(B1, 0, 1); PG8_STAGE(PG8_SB(0, 0), b2, voffB);
            PG8_BAR; PG8_WAIT_L(0); PG8_MMA(0, 1, At, B1); PG8_BAR;
            PG8_LDA(At, 0, 1); PG8_STAGE(PG8_SA(0, 0), a2, voffA);
            PG8_BAR; PG8_WAIT_L(0); PG8_MMA(1, 0, At, B0); PG8_BAR; PG8_SCHED;
            PG8_STAGE(PG8_SB(0, 1), b2 + hstep, voffB);
            PG8_WAIT_V(6); PG8_BAR; PG8_MMA(1, 1, At, B1); PG8_BAR;
            PG8_LDB(B0, 1, 0); PG8_SCHED; PG8_LDA(At, 1, 0); PG8_STAGE(PG8_SA(0, 1), a2 + hstep, voffA);
            PG8_WAIT_L(8); PG8_BAR; PG8_WAIT_L(0); PG8_MMA(0, 0, At, B0); PG8_BAR; PG8_SCHED;
            PG8_LDB(B1, 1, 1); PG8_STAGE(PG8_SB(1, 0), b3, voffB);
            PG8_BAR; PG8_WAIT_L(0); PG8_MMA(0, 1, At, B1); PG8_BAR;
            PG8_LDA(At, 1, 1); PG8_STAGE(PG8_SA(1, 0), a3, voffA);
            PG8_BAR; PG8_WAIT_L(0); PG8_MMA(1, 0, At, B0); PG8_BAR; PG8_SCHED;
            PG8_STAGE(PG8_SB(1, 1), b3 + hstep, voffB);
            PG8_WAIT_V(6); PG8_BAR; PG8_MMA(1, 1, At, B1); PG8_BAR;
            }
        }
        if constexpr (ALIGN_EPI) { if (wr == 0) PG8_BAR; }
        if constexpr (STRIP) { E.strip(accS, cur, (LAS float*)(lds + RS_OFF), wr, wc, fr, fq); accS[0] = accS[1] = (f32x4){0.f, 0.f, 0.f, 0.f}; sA = nsA; }
        E(acc, cur, (const LAS float*)(S.rs + ui * 256), wr, wc, fr, fq);
        if (!has_next) break;
#pragma unroll
        for (int a = 0; a < 2; ++a)
#pragma unroll
            for (int b = 0; b < 2; ++b)
#pragma unroll
                for (int m = 0; m < 4; ++m)
#pragma unroll
                    for (int n = 0; n < 2; ++n) acc[a][b][m][n] = (f32x4){0.f, 0.f, 0.f, 0.f};
        cur = nxt; cA = nA; cB = nB; ++ui;
        if constexpr (ALIGN_EPI) { if (wr == 1) PG8_BAR; }
    }
    PG8_WAIT_V(0);
    if constexpr (!ALIGN_EPI) { if (wr == 0) PG8_BAR; }
    PG8_BAR;
#undef PG8_SA
#undef PG8_SB
#undef PG8_STAGE
#undef PG8_SSTG
#undef PG8_LDS
#undef PG8_SMMA
#undef PG8_LDA
#undef PG8_LDB
#undef PG8_MMA
#undef PG8_WAIT_V
#undef PG8_WAIT_L
#undef PG8_WAIT_L0
#undef PG8_BAR
#undef PG8_SCHED
}
}
using pg8::Unit;

struct EpiSwiGLU {
    bf16_t* O;
    DI void operator()(f32x4 (&acc)[2][2][4][2], const Unit& u, const LAS float* rs, int wr, int wc, int fr, int fq) const {
        const int col0 = u.pn * 128 + wc * 32 + 8 * fq;
#pragma unroll
        for (int ai = 0; ai < 2; ++ai)
#pragma unroll
            for (int m = 0; m < 4; ++m) {
                const int rl = ai * 128 + wr * 64 + m * 16 + fr; const float r = rs[rl], rn = -r * LOG2E, rr = r * r;
                f32x2 o[4];
#pragma unroll
                for (int n = 0; n < 2; ++n)
#pragma unroll
                    for (int h = 0; h < 2; ++h) {
                        const f32x2 g = {acc[ai][0][m][n][2 * h], acc[ai][0][m][n][2 * h + 1]}, uu = {acc[ai][1][m][n][2 * h], acc[ai][1][m][n][2 * h + 1]};
                        const f32x2 w = g * rn;
                        const f32x2 d = (f32x2){__builtin_amdgcn_exp2f(w.x), __builtin_amdgcn_exp2f(w.y)} + 1.0f;
                        const f32x2 sg = (f32x2){__builtin_amdgcn_rcpf(d.x), __builtin_amdgcn_rcpf(d.y)} * rr;
                        o[n * 2 + h] = (g * uu) * sg; }
                u32x4 w; w.x = pk2(o[0].x, o[0].y); w.y = pk2(o[1].x, o[1].y); w.z = pk2(o[2].x, o[2].y); w.w = pk2(o[3].x, o[3].y);
                *(u32x4*)(O + (size_t)(u.pm * 256 + rl) * FF + col0) = w;
            }
    }
};
struct EpiResid {
    const float* in_lo; const float* in_hi;
    bf16_t* XB; float* ssp; float s;
    DI void operator()(f32x4 (&acc)[2][2][4][2], const Unit& u, const LAS float* rs, int wr, int wc, int fr, int fq) const { run(acc, u, wr, wc, fr, fq); }
    DI void run(const f32x4 (&acc)[2][2][4][2], const Unit& u, int wr, int wc, int fr, int fq) const {
        u32x4 xr[2][4][2];
#pragma unroll
        for (int ai = 0; ai < 2; ++ai)
#pragma unroll
            for (int m = 0; m < 4; ++m)
#pragma unroll
                for (int bj = 0; bj < 2; ++bj)
                    xr[ai][m][bj] = *(const u32x4*)(XB + (size_t)(u.pm * 256 + ai * 128 + wr * 64 + m * 16 + fr) * DM + u.pn * 256 + bj * 128 + wc * 32 + 8 * fq);
        asm volatile("" ::: "memory");
#pragma unroll
        for (int ai = 0; ai < 2; ++ai) {
#pragma unroll
            for (int m = 0; m < 4; ++m) {
                const int row = u.pm * 256 + ai * 128 + wr * 64 + m * 16 + fr; f32x2 q2 = {0.f, 0.f};
#pragma unroll
                for (int bj = 0; bj < 2; ++bj) {
                    const size_t off = (size_t)row * DM + u.pn * 256 + bj * 128 + wc * 32 + 8 * fq; const u32x4 x = xr[ai][m][bj];
                    const f32x4 a = (f32x4){bflo(x.x), bfhi(x.x), bflo(x.y), bfhi(x.y)} + acc[ai][bj][m][0] * s, b = (f32x4){bflo(x.z), bfhi(x.z), bflo(x.w), bfhi(x.w)} + acc[ai][bj][m][1] * s;
                    u32x4 w; w.x = pk2(a[0], a[1]); w.y = pk2(a[2], a[3]); w.z = pk2(b[0], b[1]); w.w = pk2(b[2], b[3]);
                    *(u32x4*)(XB + off) = w;
                    const f32x2 a0 = {a[0], a[1]}, a1 = {a[2], a[3]}, b0 = {b[0], b[1]}, b1 = {b[2], b[3]};
                    q2 = q2 + a0 * a0; q2 = q2 + a1 * a1; q2 = q2 + b0 * b0; q2 = q2 + b1 * b1;
                }
                float q = q2.x + q2.y; q += __shfl_xor(q, 16); q += __shfl_xor(q, 32);
                if (fq == 0) ssp[(size_t)(u.pn * 4 + wc) * MROWS + row] = q;
            }
        }
        asm volatile("" ::: "memory");
    }
    DI void strip(const f32x4 (&accS)[2], const Unit& u, LAS float* ls, int wr, int wc, int fr, int fq) const {
        asm volatile("" : "+v"(fr), "+v"(fq));
        const int row = MP + (u.pm >> 1) * 16 + fr, bj = u.pm & 1;
        if (wr == 0) {
            const size_t off = (size_t)row * DM + u.pn * 256 + bj * 128 + wc * 32 + 8 * fq;
            const u32x4 x = *(const u32x4*)(XB + off);
            const f32x4 a = (f32x4){bflo(x.x), bfhi(x.x), bflo(x.y), bfhi(x.y)} + accS[0] * s, b = (f32x4){bflo(x.z), bfhi(x.z), bflo(x.w), bfhi(x.w)} + accS[1] * s;
            u32x4 w; w.x = pk2(a[0], a[1]); w.y = pk2(a[2], a[3]); w.z = pk2(b[0], b[1]); w.w = pk2(b[2], b[3]);
            *(u32x4*)(XB + off) = w;
            float q = (a[0] * a[0] + a[1] * a[1]) + (a[2] * a[2] + a[3] * a[3]) + (b[0] * b[0] + b[1] * b[1]) + (b[2] * b[2] + b[3] * b[3]);
            q += __shfl_xor(q, 16); q += __shfl_xor(q, 32);
            if (fq == 0) ls[fr * 4 + wc] = q;
        }
        asm volatile("s_waitcnt lgkmcnt(0)" ::: "memory"); __builtin_amdgcn_s_barrier(); asm volatile("" ::: "memory");
        if (wr == 0 && wc == 0 && fq < 2) {
            const float p = ls[fr * 4 + 2 * fq] + ls[fr * 4 + 2 * fq + 1];
            ssp[(size_t)(u.pn * 4 + bj * 2 + fq) * MROWS + row] = p; }
    }
};
struct EpiFinal {
    bf16_t* XB; float s; float* Y; const float* gain; float* xs; unsigned* cnt;
    DI void operator()(f32x4 (&acc)[2][2][4][2], const Unit& u, const LAS float* rs, int wr, int wc, int fr, int fq) const { run_final(acc, u, (LAS float*)rs, wr, wc, fr, fq); }
    DI void run_final(f32x4 (&acc)[2][2][4][2], const Unit& u, LAS float* ls, int wr, int wc, int fr, int fq) const {
        const int tid = (wr * 4 + wc) * 64 + fq * 16 + fr;
#pragma unroll
        for (int ai = 0; ai < 2; ++ai) {
#pragma unroll
            for (int m = 0; m < 4; ++m) { float q = 0.f; u32x4 xin[2];
#pragma unroll
                for (int bj = 0; bj < 2; ++bj) xin[bj] = *(const u32x4*)(XB + (size_t)(u.pm * 256 + ai * 128 + wr * 64 + m * 16 + fr) * DM + u.pn * 256 + bj * 128 + wc * 32 + 8 * fq);
#pragma unroll
                for (int bj = 0; bj < 2; ++bj) { const u32x4 x = xin[bj];
                    const f32x4 a = (f32x4){bflo(x.x), bfhi(x.x), bflo(x.y), bfhi(x.y)} + acc[ai][bj][m][0] * s, b = (f32x4){bflo(x.z), bfhi(x.z), bflo(x.w), bfhi(x.w)} + acc[ai][bj][m][1] * s;
                    acc[ai][bj][m][0] = a; acc[ai][bj][m][1] = b;
                    q += (a[0] * a[0] + a[1] * a[1]) + (a[2] * a[2] + a[3] * a[3]) + (b[0] * b[0] + b[1] * b[1]) + (b[2] * b[2] + b[3] * b[3]); }
                q += __shfl_xor(q, 16); q += __shfl_xor(q, 32);
                if (fq == 0) ls[(ai * 128 + wr * 64 + m * 16 + fr) * 4 + wc] = q; }
        }
        asm volatile("s_waitcnt lgkmcnt(0)" ::: "memory"); __builtin_amdgcn_s_barrier(); asm volatile("" ::: "memory");
        if (tid < 256) { const float p = (ls[tid * 4] + ls[tid * 4 + 1]) + (ls[tid * 4 + 2] + ls[tid * 4 + 3]); st4_wt(xs + (size_t)(u.pm * 256 + tid) * 4 + u.pn, p); }
        asm volatile("s_waitcnt vmcnt(0) lgkmcnt(0)" ::: "memory"); __builtin_amdgcn_s_barrier(); asm volatile("" ::: "memory");
        if (tid == 0) { __hip_atomic_fetch_add(cnt + 64 * u.pm, 1u, __ATOMIC_RELAXED, __HIP_MEMORY_SCOPE_AGENT); wait_count(cnt + 64 * u.pm, 4u); }
        asm volatile("" ::: "memory"); __builtin_amdgcn_s_barrier(); asm volatile("" ::: "memory");
        if (tid < 256) { const f32x4 p4 = *(const f32x4*)(xs + (size_t)(u.pm * 256 + tid) * 4); ls[1024 + tid] = rsqrtf(((p4[0] + p4[1]) + (p4[2] + p4[3])) * (1.0f / DM) + EPS); }
        asm volatile("s_waitcnt vmcnt(0) lgkmcnt(0)" ::: "memory"); __builtin_amdgcn_s_barrier(); asm volatile("" ::: "memory");
#pragma unroll
        for (int ai = 0; ai < 2; ++ai)
#pragma unroll
            for (int m = 0; m < 4; ++m) { const int rl = ai * 128 + wr * 64 + m * 16 + fr; const float r = ls[1024 + rl];
#pragma unroll
                for (int bj = 0; bj < 2; ++bj) { const int col = u.pn * 256 + bj * 128 + wc * 32 + 8 * fq; const size_t off = (size_t)(u.pm * 256 + rl) * DM + col;
                    *(f32x4*)(Y + off) = acc[ai][bj][m][0] * r * *(const f32x4*)(gain + col); *(f32x4*)(Y + off + 4) = acc[ai][bj][m][1] * r * *(const f32x4*)(gain + col + 4); } }
    }
};
struct EpiProj0 {
    bf16_t *Q, *K, *V, *UP;
    DI void operator()(f32x4 (&acc)[2][2][4][2], const Unit& u, const LAS float* rs, int wr, int wc, int fr, int fq) const {
#pragma unroll
        for (int bj = 0; bj < 2; ++bj) {
            bf16_t* base; int pitch, c0; float sc = 1.f;
            if (u.pn < 2) { base = Q; pitch = 512; c0 = u.pn * 256 + bj * 128; sc = 0.125f; }
            else if (u.pn == 2) { base = bj ? V : K; pitch = 128; c0 = 0; }
            else { base = UP; pitch = 512; c0 = (u.pn - 3) * 256 + bj * 128; }
            c0 += wc * 32 + 8 * fq;
#pragma unroll
            for (int ai = 0; ai < 2; ++ai)
#pragma unroll
                for (int m = 0; m < 4; ++m) {
                    const int rl = ai * 128 + wr * 64 + m * 16 + fr; const float r = rs[rl] * sc;
                    const f32x4 a = acc[ai][bj][m][0] * r, b = acc[ai][bj][m][1] * r;
                    u32x4 w; w.x = pk2(a[0], a[1]); w.y = pk2(a[2], a[3]); w.z = pk2(b[0], b[1]); w.w = pk2(b[2], b[3]);
                    *(u32x4*)(base + (size_t)(u.pm * 256 + rl) * pitch + c0) = w;
                }
        }
    }
};
constexpr float GELU_A = -1.5957691216057308f * LOG2E, GELU_B = GELU_A * 0.044715f;
DI float gelu_tanh(float x) { const float u2 = 1.5957691216057308f * (x + 0.044715f * x * x * x); return x * __builtin_amdgcn_rcpf(1.0f + __builtin_amdgcn_exp2f(-u2 * LOG2E)); }
struct EpiGeluUV {
    bf16_t *U, *V1; float* ssp;
    DI void operator()(f32x4 (&acc)[2][2][4][2], const Unit& u, const LAS float* rs, int wr, int wc, int fr, int fq) const {
        const bool isv = u.pn >= 4; bf16_t* base = isv ? V1 : U; const int pc = (isv ? u.pn - 4 : u.pn) * 256;
#pragma unroll
        for (int ai = 0; ai < 2; ++ai)
#pragma unroll
            for (int m = 0; m < 4; ++m) {
                const int rl = ai * 128 + wr * 64 + m * 16 + fr, row = u.pm * 256 + rl; const float r = rs[rl]; f32x2 q2 = {0.f, 0.f};
#pragma unroll
                for (int bj = 0; bj < 2; ++bj) {
                    f32x2 o[4], xx[4], ww[4], dd[4];
#pragma unroll
                    for (int p = 0; p < 4; ++p) { xx[p] = (f32x2){acc[ai][bj][m][p >> 1][2 * (p & 1)], acc[ai][bj][m][p >> 1][2 * (p & 1) + 1]} * r; ww[p] = xx[p] * ((xx[p] * xx[p]) * GELU_B + GELU_A); }
#pragma unroll
                    for (int p = 0; p < 4; ++p) dd[p] = (f32x2){__builtin_amdgcn_exp2f(ww[p].x), __builtin_amdgcn_exp2f(ww[p].y)};
#pragma unroll
                    for (int p = 0; p < 4; ++p) dd[p] = dd[p] + 1.0f;
#pragma unroll
                    for (int p = 0; p < 4; ++p) dd[p] = (f32x2){__builtin_amdgcn_rcpf(dd[p].x), __builtin_amdgcn_rcpf(dd[p].y)};
#pragma unroll
                    for (int p = 0; p < 4; ++p) { o[p] = xx[p] * dd[p]; q2 = q2 + o[p] * o[p]; }
                    u32x4 w; w.x = pk2(o[0].x, o[0].y); w.y = pk2(o[1].x, o[1].y); w.z = pk2(o[2].x, o[2].y); w.w = pk2(o[3].x, o[3].y);
                    *(u32x4*)(base + (size_t)row * DM + pc + bj * 128 + wc * 32 + 8 * fq) = w;
                }
                if (isv) { float q = q2.x + q2.y; q += __shfl_xor(q, 16); q += __shfl_xor(q, 32); if (fq == 0) ssp[(size_t)((u.pn - 4) * 4 + wc) * MROWS + row] = q; }
            }
    }
};

#define XB_TMO      128
#define XB_XCNT(j)  (256  + 64 * (j))
#define XB_XSUB(j)  (1280 + 64 * (j))
#define XB_XGEN(j)  (2304 + 64 * (j))
#define XB_TOP      3328
#define XB_TOPGEN   3392
#define XCD_BAR_WORDS 3456
#define XB_SPIN_CAP (1u << 18)
DI unsigned xb_ld(unsigned* p)              { return __hip_atomic_load(p, __ATOMIC_RELAXED, __HIP_MEMORY_SCOPE_AGENT); }
DI unsigned xb_add(unsigned* p, unsigned v) { return __hip_atomic_fetch_add(p, v, __ATOMIC_RELAXED, __HIP_MEMORY_SCOPE_AGENT); }
DI unsigned xb_xcc_id() { return (unsigned)__builtin_amdgcn_s_getreg((3 << 11) | 20) & 0xFu; }
#define XB_SPIN(cond, bar) do { unsigned _sp = 0; while (cond) { __builtin_amdgcn_s_sleep(1); \
    if ((++_sp & 255u) == 0u) { if (xb_ld(&(bar)[XB_TMO])) break; if (_sp > XB_SPIN_CAP) { atomicAdd(&(bar)[XB_TMO], 1u); break; } } } } while (0)
struct XcdBarrier { unsigned* bar; unsigned x; volatile LAS unsigned* st; };
DI XcdBarrier xcd_barrier_post(unsigned* bar, volatile LAS unsigned* st) {
    XcdBarrier b; b.bar = bar; b.x = xb_xcc_id(); b.st = st;
    if (threadIdx.x == 0) (void)xb_add(&bar[XB_XCNT(b.x)], 1u);
    return b;
}
DI void xcd_barrier_complete(unsigned* bar, unsigned x, unsigned& nloc, unsigned& nx) {
    const unsigned G = GRID;
    unsigned sum, cnt, mine, sp = 0u;
    for (;;) {
        sum = 0u; cnt = 0u; mine = 0u;
#pragma unroll
        for (unsigned j = 0; j < 16; ++j) { const unsigned c = xb_ld(&bar[XB_XCNT(j)]); sum += c; cnt += (c > 0u) ? 1u : 0u; mine = (j == x) ? c : mine; }
        if (sum == G) break;
        __builtin_amdgcn_s_sleep(1);
        if ((++sp & 255u) == 0u) { if (xb_ld(&bar[XB_TMO])) break; if (sp > XB_SPIN_CAP) { atomicAdd(&bar[XB_TMO], 1u); break; } }
    }
    nloc = mine > 0u ? mine : 1u; nx = cnt > 0u ? cnt : 1u;
}
DI void xcd_barrier(const XcdBarrier& b) {
    asm volatile("s_waitcnt vmcnt(0)" ::: "memory");
    __syncthreads();
    if (threadIdx.x == 0) {
        unsigned* bar = b.bar;
        __builtin_amdgcn_s_waitcnt(0);
        unsigned nloc = b.st[0], nx = b.st[1];
        if (nloc == 0u) { xcd_barrier_complete(bar, b.x, nloc, nx); b.st[0] = nloc; b.st[1] = nx; }
        const unsigned old = xb_add(&bar[XB_XSUB(b.x)], 1u);
        const unsigned gen = old / nloc;
        if (old + 1u == (gen + 1u) * nloc) {
            asm volatile("buffer_inv sc1" ::: "memory");
            __builtin_amdgcn_fence(__ATOMIC_RELEASE, "agent");
            asm volatile("s_waitcnt vmcnt(0)" ::: "memory");
            const unsigned og = xb_add(&bar[XB_TOP], 1u);
            const unsigned tg = og / nx;
            if (og + 1u == (tg + 1u) * nx) xb_add(&bar[XB_TOPGEN], 1u);
            else XB_SPIN(xb_ld(&bar[XB_TOPGEN]) == tg, bar);
            xb_add(&bar[XB_XGEN(b.x)], 1u);
            asm volatile("s_waitcnt vmcnt(0)" ::: "memory");
        } else {
            asm volatile("buffer_inv sc1" ::: "memory");
            XB_SPIN(xb_ld(&bar[XB_XGEN(b.x)]) == gen, bar);
            asm volatile("s_waitcnt vmcnt(0)" ::: "memory");
        }
    }
    __syncthreads();
}

struct TrD { const float* W; const float* gain; bf16_t* WT; int K, N, mode, item; };
DI void tr_load(const TrD& d, int lane, f32x4 (&v)[8], float (&g)[8]) {
    const int nblk = d.N / 32, kb = d.item / nblk, nb = d.item % nblk, k0 = 64 * kb, n0 = 32 * nb, kr = lane >> 3, n4 = (lane & 7) * 4;
#pragma unroll
    for (int i = 0; i < 8; ++i) v[i] = *(const f32x4*)(d.W + (size_t)(k0 + 8 * i + kr) * d.N + n0 + n4);
#pragma unroll
    for (int i = 0; i < 8; ++i) g[i] = d.gain ? d.gain[k0 + 8 * i + kr] : 1.0f;
}
DI void tr_finish(const TrD& d, LAS float* scr, int lane, const f32x4 (&v)[8], const float (&g)[8]) {
    const int nblk = d.N / 32, kb = d.item / nblk, nb = d.item % nblk, k0 = 64 * kb, n0 = 32 * nb, kr = lane >> 3, n4 = (lane & 7) * 4;
#pragma unroll
    for (int i = 0; i < 8; ++i) { LAS float* p = scr + (8 * i + kr) * 33 + n4; p[0] = v[i][0] * g[i]; p[1] = v[i][1] * g[i]; p[2] = v[i][2] * g[i]; p[3] = v[i][3] * g[i]; }
    asm volatile("s_waitcnt lgkmcnt(0)" ::: "memory");
    const int c = lane & 7;
#pragma unroll
    for (int j = 0; j < 4; ++j) { const int n = (lane >> 3) + 8 * j; const LAS float* s = scr + (8 * c) * 33 + n;
        u32x4 o; o.x = pk2(s[0 * 33], s[1 * 33]); o.y = pk2(s[2 * 33], s[3 * 33]); o.z = pk2(s[4 * 33], s[5 * 33]); o.w = pk2(s[6 * 33], s[7 * 33]);
        const int ng = n0 + n; const int row = d.mode == 0 ? ng : ((ng >> 7) * 256 + (ng & 127) + (d.mode == 2 ? 128 : 0));
        *(u32x4*)(d.WT + (size_t)row * d.K + k0 + 8 * c) = o; }
    asm volatile("s_waitcnt lgkmcnt(0)" ::: "memory");
}

struct Args { const float* in[21]; float* out; unsigned char* ws; int ph_lo, ph_hi; };
#define CAS __attribute__((address_space(4)))
struct KA { const CAS char* kp;
    DI const float* in(int i) const { return *(const float* const CAS*)(kp + 8 * i); }
    DI float* out() const { return *(float* const CAS*)(kp + 168); }
    DI unsigned char* ws() const { return *(unsigned char* const CAS*)(kp + 176); } };
static_assert(sizeof(Args) == 192, "Args layout");

DI void convert_set(const KA& a, LAS unsigned char* lds, int set, int ww, int nww, int wave, int lane) {
    asm volatile("" : "+v"(lane));
    unsigned char* ws = a.ws();
    LAS float* scr = (LAS float*)(lds + wave * 16384);
    const float* gains = a.in(6);
    constexpr int I_GU = (DM / 64) * (FF / 32), I_D = (FF / 64) * (DM / 32), I_IN0 = (DM / 64) * (NIN0 / 32), I_SQ = (DM / 64) * (DM / 32), I_IN1 = (DM / 64) * (NIN1 / 32), I_P = 2 * 4;
    auto mat_items = [&](int id) -> int { return id < 8 ? I_GU : id < 12 ? I_D : id == 12 ? I_IN0 : id == 14 ? I_IN1 : id < 16 ? I_SQ : I_P; };
    auto mat_desc = [&](int id, int item) -> TrD {
        if (id < 8) { const int lh = id & 3, up = id >> 2, l = lh >> 1, h = lh & 1;
            return TrD{a.in(up ? 9 : 8) + (size_t)lh * DM * FF, gains + (l * 3 + (h ? 2 : 0)) * DM, (bf16_t*)(ws + WS_WGU + lh * SZ_WGU), DM, FF, 1 + up, item}; }
        if (id < 12) { const int lh = id - 8; return TrD{a.in(10) + (size_t)lh * FF * DM, nullptr, (bf16_t*)(ws + WS_WD + lh * SZ_WD), FF, DM, 0, item}; }
        if (id == 12) return TrD{a.in(11), gains + 1 * DM, (bf16_t*)(ws + WS_WIN0), DM, NIN0, 0, item};
        if (id == 13) return TrD{a.in(12), nullptr, (bf16_t*)(ws + WS_WOUT0), DM, DM, 0, item};
        if (id == 14) return TrD{a.in(16), gains + 4 * DM, (bf16_t*)(ws + WS_WIN1), DM, NIN1, 0, item};
        if (id == 15) return TrD{a.in(20), nullptr, (bf16_t*)(ws + WS_WOUT1), DM, DM, 0, item};
        const int g = id - 16; return TrD{a.in(14) + (size_t)g * 128 * 128, nullptr, (bf16_t*)(ws + WS_WPT) + (size_t)g * 128 * 128, 128, 128, 0, item};
    };
    const unsigned long long lists[4] = { 0ull | (4ull << 5) | (16ull << 10) | (17ull << 15) | (18ull << 20) | (19ull << 25),
                                          8ull | (12ull << 5) | (13ull << 10),
                                          1ull | (5ull << 5) | (9ull << 10) | (2ull << 15) | (6ull << 20) | (10ull << 25) | (14ull << 30) | (15ull << 35),
                                          3ull | (7ull << 5) | (11ull << 10) };
    const int counts[4] = {6, 3, 8, 3};
    const unsigned long long lst = set == 0 ? lists[0] : set == 1 ? lists[1] : set == 2 ? lists[2] : lists[3];
    const int cnt = set == 0 ? counts[0] : set == 1 ? counts[1] : set == 2 ? counts[2] : counts[3];
    int total = 0;
    for (int k = 0; k < cnt; ++k) total += mat_items((int)((lst >> (5 * k)) & 31ull));
    auto decode = [&](int it) -> TrD { int r = it; int id = 0;
        for (int k = 0; k < cnt; ++k) { id = (int)((lst >> (5 * k)) & 31ull); const int n = mat_items(id); if (r < n) break; r -= n; }
        return mat_desc(id, r); };
    {
        f32x4 va[8], vb[8]; float ga[8], gb[8]; TrD d0, d1;
        int it = ww;
        if (it < total) { d0 = decode(it); tr_load(d0, lane, va, ga); }
#pragma unroll 1
        for (; it < total; it += 2 * nww) {
            const bool has1 = it + nww < total;
            if (has1) { d1 = decode(it + nww); tr_load(d1, lane, vb, gb); }
            tr_finish(d0, scr, lane, va, ga);
            if (!has1) break;
            const bool has2 = it + 2 * nww < total;
            if (has2) { d0 = decode(it + 2 * nww); tr_load(d0, lane, va, ga); }
            tr_finish(d1, scr, lane, vb, gb);
            if (!has2) break;
        }
    }
}
DI void prologue(const KA& a, LAS unsigned char* lds, int gw, int NGW, int wave, int lane) {
    unsigned char* ws = a.ws();
    convert_set(a, lds, 0, gw, NGW, wave, lane);
    const int gt = gw * 64 + lane, NGT = NGW * 64;
    { const float* wsp = a.in(18); bf16_t* wst = (bf16_t*)(ws + WS_WST);
      for (int i = gt; i < 4 * 128 * 128; i += NGT) { const int s = i & 127, t = (i >> 7) & 127; wst[i] = f2bf(s <= t ? wsp[i] : 0.f); } }
    if (gt < 8 * 128) { const int h = gt >> 7, n = gt & 127; int bk = n;
        if (n >= 16) { const float nf = (float)n; int lg = 16 + (int)(logf(nf / 16.0f) / 2.0794415416798357f * 16.0f); bk = lg < 31 ? lg : 31; }
        ((float*)(ws + WS_BIAS))[gt] = a.in(5)[bk * 8 + h]; }
    bf16_t* XB = (bf16_t*)(ws + WS_XB); float* ssp0 = (float*)(ws + WS_SSP);
    {   const float* xp = a.in(0); const float* xs = a.in(1) - (size_t)MP * DM;
        auto ldrow = [&](int m, f32x4 (&v)[4]) { const f32x4* xr = (const f32x4*)((m < MP ? xp : xs) + (size_t)m * DM) + lane;
#pragma unroll
            for (int j = 0; j < 4; ++j) v[j] = xr[64 * j]; };
        auto fin = [&](int m, const f32x4 (&v)[4]) { float s = 0.f;
#pragma unroll
            for (int j = 0; j < 4; ++j) s += (v[j].x * v[j].x + v[j].y * v[j].y) + (v[j].z * v[j].z + v[j].w * v[j].w);
            s = wave_sum(s);
            u32x2* o8 = (u32x2*)(XB + (size_t)m * DM) + lane;
#pragma unroll
            for (int j = 0; j < 4; ++j) { u32x2 w; w.x = pk2(v[j].x, v[j].y); w.y = pk2(v[j].z, v[j].w); o8[64 * j] = w; }
            if (lane < 16) ssp0[(size_t)lane * MROWS + m] = lane == 0 ? s : 0.f; };
        f32x4 v0[4], v1[4], v2[4], v3[4];
#pragma unroll 1
        for (int m = gw; m < MROWS; m += 4 * NGW) {
            const bool h1 = m + NGW < MROWS, h2 = m + 2 * NGW < MROWS, h3 = m + 3 * NGW < MROWS;
            ldrow(m, v0); if (h1) ldrow(m + NGW, v1); if (h2) ldrow(m + 2 * NGW, v2); if (h3) ldrow(m + 3 * NGW, v3);
            fin(m, v0); if (h1) fin(m + NGW, v1); if (h2) fin(m + 2 * NGW, v2); if (h3) fin(m + 3 * NGW, v3);
        }
    }
}

DI void state_copies(const KA& a, int wt, int nwt) {
    asm volatile("" : "+v"(wt));
    float* out = a.out(); const float* sk = a.in(2); const float* sv = a.in(3); const float* sp = a.in(4);
#pragma unroll 4
    for (int i4 = wt; i4 < 128 * 3968; i4 += nwt) { const int b = i4 / 3968, rem = i4 - b * 3968; const size_t o = (size_t)b * 16384 + (size_t)rem * 4;
        *(f32x4*)(out + O_KS + o) = *(const f32x4*)(sk + o + 512); *(f32x4*)(out + O_VS + o) = *(const f32x4*)(sv + o + 512); }
#pragma unroll 4
    for (int i4 = wt; i4 < 128 * 1408; i4 += nwt) { const int b = i4 / 1408, rem = i4 - b * 1408; const size_t o = (size_t)b * 7680 + (size_t)rem * 4;
        *(f32x4*)(out + O_PS + o) = *(const f32x4*)(sp + o + 2048); }
}

DI int crow(int r, int hi) { return (r & 3) + 8 * (r >> 2) + 4 * hi; }
#define MFMA32(a, b, c) __builtin_amdgcn_mfma_f32_32x32x16_bf16((a), (b), (c), 0, 0, 0)
constexpr int KS_STRIDE = 144, VT_STRIDE = 520, KS_BYTES = 256 * KS_STRIDE;

DI float softmax5(f32x16 (&sc)[5], float sink) {
    float mx = NEGV;
#pragma unroll
    for (int t = 0; t < 5; ++t)
#pragma unroll
        for (int r = 0; r < 16; ++r) mx = fmaxf(mx, sc[t][r]);
    mx = fmaxf(mx, __shfl_xor(mx, 32));
    const float m = fmaxf(mx, sink);
    float l = 0.f;
#pragma unroll
    for (int t = 0; t < 5; ++t)
#pragma unroll
        for (int r = 0; r < 16; ++r) { const float p = fexp(sc[t][r] - m); sc[t][r] = p; l += p; }
    l += __shfl_xor(l, 32);
    l += fexp(sink - m);
    return 1.0f / l;
}
DI bf16x8 pack_step(const f32x16& x, int s) {
    u32x4 p; p.x = pk2(x[8 * s], x[8 * s + 1]); p.y = pk2(x[8 * s + 2], x[8 * s + 3]); p.z = pk2(x[8 * s + 4], x[8 * s + 5]); p.w = pk2(x[8 * s + 6], x[8 * s + 7]);
    return __builtin_bit_cast(bf16x8, p);
}

constexpr int BT_OFF = KS_BYTES + 64 * VT_STRIDE;
DI void fill_bias_table(LAS float* T, const float* bT, int lane) {
#pragma unroll
    for (int i = 0; i < 4; ++i) { const int k = lane + 64 * i, dist = 159 - k; if (k < 196) T[k] = (dist >= 0 && dist < 128) ? bT[dist & 127] : NEGV; }
}
DI void attn_prompt_item(int item, int tid, LAS unsigned char* lds, const bf16_t* Q, const bf16_t* Kb, const bf16_t* Vb, bf16_t* CAT, const float* biasT, const float* sinks) {
    asm volatile("" : "+v"(tid));
    const int lane = tid & 63, wid = __builtin_amdgcn_readfirstlane(tid >> 6), r32 = lane & 31, hi = lane >> 5;
    const int kvh = item & 1, j = (item >> 1) & 15, b = item >> 5;
    const int rowq0 = b * SEQ + j * 128, rowk0 = rowq0 - 128;
    LAS unsigned char* KS = lds; LAS unsigned char* VT = lds + KS_BYTES;
    const int g = wid >> 1, qh = wid & 1, hq = kvh * 4 + g;
    LAS float* T = (LAS float*)(lds + BT_OFF) + wid * 256;
    fill_bias_table(T, biasT + hq * 128, lane);
    {
        const int ch = tid & 7, key0 = tid >> 3; u32x4 kq[4], vq[4];
#pragma unroll
        for (int k = 0; k < 4; ++k) { const int key = key0 + 64 * k; const bool ok = (j > 0) || key >= 128; const size_t o = (size_t)(ok ? rowk0 + key : rowq0 + (key & 127)) * 128 + kvh * 64 + ch * 8;
            kq[k] = *(const u32x4*)(Kb + o); vq[k] = *(const u32x4*)(Vb + o); }
#pragma unroll
        for (int k = 0; k < 4; ++k) { const int key = key0 + 64 * k; const bool ok = (j > 0) || key >= 128;
            const u32x4 kv = ok ? kq[k] : (u32x4){0u, 0u, 0u, 0u}, vv = ok ? vq[k] : (u32x4){0u, 0u, 0u, 0u};
            *(LAS u32x4*)(KS + key * KS_STRIDE + ch * 16) = kv;
#pragma unroll
            for (int i = 0; i < 4; ++i) { const unsigned w = vv[i];
                *(LAS unsigned short*)(VT + (ch * 8 + 2 * i) * VT_STRIDE + key * 2) = (unsigned short)(w & 0xffffu);
                *(LAS unsigned short*)(VT + (ch * 8 + 2 * i + 1) * VT_STRIDE + key * 2) = (unsigned short)(w >> 16); } }
    }
    __syncthreads();
    const float sink = sinks[hq];
    const LAS float* Tl = T + (31 - r32 + 4 * hi);
#pragma unroll 1
    for (int qt = 0; qt < 2; ++qt) {
        const int qo = 64 * qh + 32 * qt;
        const LAS unsigned char* kbase = KS + (qo + r32) * KS_STRIDE + hi * 16;
        const LAS unsigned char* vbase = VT + r32 * VT_STRIDE + (qo + 4 * hi) * 2;
        bf16x8 qf[4];
#pragma unroll
        for (int s = 0; s < 4; ++s) qf[s] = *(const bf16x8*)(Q + (size_t)(rowq0 + qo + r32) * 512 + hq * 64 + 16 * s + 8 * hi);
        f32x16 sc[5];
#pragma unroll
        for (int t = 0; t < 5; ++t) {
            f32x16 acc; bf16x8 kf[4];
#pragma unroll
            for (int r = 0; r < 16; ++r) acc[r] = Tl[32 * t + (r & 3) + 8 * (r >> 2)];
#pragma unroll
            for (int s = 0; s < 4; ++s) kf[s] = *(const LAS bf16x8*)(kbase + t * 32 * KS_STRIDE + s * 32);
#pragma unroll
            for (int s = 0; s < 4; ++s) acc = MFMA32(kf[s], qf[s], acc);
            sc[t] = acc;
        }
        if (j == 0) {
            const int lim = qo + r32, d0 = 128 + r32 - 4 * hi;
#pragma unroll
            for (int t = 0; t < 5; ++t)
#pragma unroll
                for (int r = 0; r < 16; ++r) { const int dist = d0 - (32 * t + (r & 3) + 8 * (r >> 2)); if (dist > lim) sc[t][r] = NEGV; }
        }
        const float linv = softmax5(sc, sink);
        f32x16 o0 = {}, o1 = {};
#pragma unroll
        for (int t = 0; t < 5; ++t)
#pragma unroll
            for (int ks = 0; ks < 2; ++ks) {
                const bf16x8 pa = pack_step(sc[t], ks); const LAS unsigned char* vp = vbase + (32 * t + 16 * ks) * 2;
                { const u32x2 lo = *(const LAS u32x2*)(vp), h2 = *(const LAS u32x2*)(vp + 16);
                  const u32x4 vb = {lo.x, lo.y, h2.x, h2.y}; o0 = MFMA32(pa, __builtin_bit_cast(bf16x8, vb), o0); }
                { const u32x2 lo = *(const LAS u32x2*)(vp + 32 * VT_STRIDE), h2 = *(const LAS u32x2*)(vp + 32 * VT_STRIDE + 16);
                  const u32x4 vb = {lo.x, lo.y, h2.x, h2.y}; o1 = MFMA32(pa, __builtin_bit_cast(bf16x8, vb), o1); }
            }
#pragma unroll
        for (int r = 0; r < 16; ++r) { const int qq = crow(r, hi); const float li = __shfl(linv, qq);
            bf16_t* op = CAT + (size_t)(rowq0 + qo + qq) * DM + hq * 64 + r32;
            op[0] = f2bf(o0[r] * li); op[32] = f2bf(o1[r] * li); }
    }
    __syncthreads();
}

constexpr int SKS_OFF = 86016, SVT_STRIDE = 328, SVT_OFF = SKS_OFF + 160 * KS_STRIDE;
static_assert(SVT_OFF + 64 * SVT_STRIDE <= RING_BYTES && BT_OFF + 12 * 1024 <= SKS_OFF, "sample attention LDS map");
DI void attn_sample_item(int item, int tid, LAS unsigned char* lds, const bf16_t* Q, const bf16_t* Kb, const bf16_t* Vb, const float* sk, const float* sv, bf16_t* CAT, const float* biasT, const float* sinks) {
    asm volatile("" : "+v"(tid));
    const int lane = tid & 63, wid = __builtin_amdgcn_readfirstlane(tid >> 6), r32 = lane & 31, hi = lane >> 5, kvh = item & 1, b = item >> 1;
    LAS unsigned char* KS = lds + SKS_OFF; LAS unsigned char* VT = lds + SVT_OFF;
    LAS float* T4 = (LAS float*)(lds + BT_OFF) + 8 * 256;
    if (wid < 4) fill_bias_table(T4 + wid * 256, biasT + (kvh * 4 + wid) * 128, lane);
    {
        const int ch = tid & 7, key0 = tid >> 3; f32x4 kf[2][2], vf[2][2]; u32x4 kn = (u32x4){0u, 0u, 0u, 0u}, vn = kn;
#pragma unroll
        for (int k = 0; k < 2; ++k) { const size_t o = ((size_t)(b * 128 + key0 + 64 * k) * 2 + kvh) * 64 + ch * 8;
            kf[k][0] = *(const f32x4*)(sk + o); kf[k][1] = *(const f32x4*)(sk + o + 4); vf[k][0] = *(const f32x4*)(sv + o); vf[k][1] = *(const f32x4*)(sv + o + 4); }
        if (key0 < 4) { const size_t o = (size_t)(MP + b * 4 + key0) * 128 + kvh * 64 + ch * 8; kn = *(const u32x4*)(Kb + o); vn = *(const u32x4*)(Vb + o); }
#pragma unroll
        for (int k = 0; k < 3; ++k) { const int key = key0 + 64 * k; if (k == 2 && key0 >= 32) break;
            const u32x4 kv = k < 2 ? (u32x4){pk2(kf[k & 1][0][0], kf[k & 1][0][1]), pk2(kf[k & 1][0][2], kf[k & 1][0][3]), pk2(kf[k & 1][1][0], kf[k & 1][1][1]), pk2(kf[k & 1][1][2], kf[k & 1][1][3])} : kn;
            const u32x4 vv = k < 2 ? (u32x4){pk2(vf[k & 1][0][0], vf[k & 1][0][1]), pk2(vf[k & 1][0][2], vf[k & 1][0][3]), pk2(vf[k & 1][1][0], vf[k & 1][1][1]), pk2(vf[k & 1][1][2], vf[k & 1][1][3])} : vn;
            *(LAS u32x4*)(KS + key * KS_STRIDE + ch * 16) = kv;
#pragma unroll
            for (int i = 0; i < 4; ++i) { const unsigned w = vv[i];
                *(LAS unsigned short*)(VT + (ch * 8 + 2 * i) * SVT_STRIDE + key * 2) = (unsigned short)(w & 0xffffu);
                *(LAS unsigned short*)(VT + (ch * 8 + 2 * i + 1) * SVT_STRIDE + key * 2) = (unsigned short)(w >> 16); } }
    }
    __syncthreads();
    if (wid != 0) return;
    const int c = r32, g = (c >> 2) & 3, t = c & 3, hq = kvh * 4 + g; const bool cval = c < 16;
    const LAS float* Tl = T4 + g * 256 + (31 - t + 4 * hi);
    const LAS unsigned char* kbase = KS + r32 * KS_STRIDE + hi * 16;
    const LAS unsigned char* vbase = VT + r32 * SVT_STRIDE + (4 * hi) * 2;
    bf16x8 qf[4];
#pragma unroll
    for (int s = 0; s < 4; ++s) { qf[s] = (bf16x8){0, 0, 0, 0, 0, 0, 0, 0}; if (cval) qf[s] = *(const bf16x8*)(Q + (size_t)(MP + b * 4 + t) * 512 + hq * 64 + 16 * s + 8 * hi); }
    f32x16 sc[5];
#pragma unroll
    for (int kt = 0; kt < 5; ++kt) {
        f32x16 acc; bf16x8 kf[4];
#pragma unroll
        for (int r = 0; r < 16; ++r) acc[r] = Tl[32 * kt + (r & 3) + 8 * (r >> 2)];
#pragma unroll
        for (int s = 0; s < 4; ++s) kf[s] = *(const LAS bf16x8*)(kbase + kt * 32 * KS_STRIDE + s * 32);
#pragma unroll
        for (int s = 0; s < 4; ++s) acc = MFMA32(kf[s], qf[s], acc);
        sc[kt] = acc;
    }
    const float linv = softmax5(sc, sinks[hq]);
    f32x16 o0 = {}, o1 = {};
#pragma unroll
    for (int kt = 0; kt < 5; ++kt)
#pragma unroll
        for (int ks = 0; ks < 2; ++ks) {
            const bf16x8 pa = pack_step(sc[kt], ks); const LAS unsigned char* vp = vbase + (32 * kt + 16 * ks) * 2;
            { const u32x2 lo = *(const LAS u32x2*)(vp), h2 = *(const LAS u32x2*)(vp + 16);
              const u32x4 vb = {lo.x, lo.y, h2.x, h2.y}; o0 = MFMA32(pa, __builtin_bit_cast(bf16x8, vb), o0); }
            { const u32x2 lo = *(const LAS u32x2*)(vp + 32 * SVT_STRIDE), h2 = *(const LAS u32x2*)(vp + 32 * SVT_STRIDE + 16);
              const u32x4 vb = {lo.x, lo.y, h2.x, h2.y}; o1 = MFMA32(pa, __builtin_bit_cast(bf16x8, vb), o1); }
        }
#pragma unroll
    for (int r = 0; r < 8; ++r) { const int cc = crow(r, hi); const float li = __shfl(linv, cc); const int gg = cc >> 2, tt = cc & 3;
        bf16_t* op = CAT + (size_t)(MP + b * 4 + tt) * DM + (kvh * 4 + gg) * 64 + r32;
        op[0] = f2bf(o0[r] * li); op[32] = f2bf(o1[r] * li); }
}

constexpr int PD_STRIDE = 272, PD_BYTES = 32 * PD_STRIDE;
template <int W> DI void pool_fill(int row0, int g, LAS unsigned char* dl, const bf16_t* UP, const float* spool, int lane) {
    const int cl = 2 * lane, cg = g * 128 + cl;
    if (row0 < MP) {
        const int tpos0 = row0 & (SEQ - 1);
        constexpr int NR = 31 + W;
        float z0[NR], z1[NR];
#pragma unroll
        for (int q = 0; q < NR; ++q) { const int d = q - (W - 1); const bool ok = (tpos0 + d) >= 0; const int rr = ok ? row0 + d : row0;
            const unsigned u = *(const unsigned*)(UP + (size_t)rr * 512 + cg); z0[q] = ok ? bflo(u) : 0.f; z1[q] = ok ? bfhi(u) : 0.f; }
        float s0 = 0.f, s1 = 0.f;
#pragma unroll
        for (int q = 0; q < W - 1; ++q) { s0 += z0[q]; s1 += z1[q]; }
#pragma unroll
        for (int i = 0; i < 32; ++i) { s0 += z0[W - 1 + i]; s1 += z1[W - 1 + i]; const int c = tpos0 + i + 1; const float inv = (c < W) ? 1.0f / (float)c : 1.0f / (float)W;
            *(LAS unsigned*)(dl + i * PD_STRIDE + cl * 2) = pk2(s0 * inv - z0[W - 1 + i], s1 * inv - z1[W - 1 + i]); s0 -= z0[i]; s1 -= z1[i]; }
    } else {
        const int b0 = (row0 - MP) >> 2;
#pragma unroll 1
        for (int bb = 0; bb < 8; ++bb) { const int bq = b0 + bb;
            constexpr int NZ = W + 3; float z0[NZ], z1[NZ];
#pragma unroll
            for (int q = 0; q < NZ; ++q) { const int j = 16 - W + q;
                if (j < 15) { const f32x2 f = *(const f32x2*)(spool + ((size_t)bq * 15 + j) * 512 + cg); z0[q] = f.x; z1[q] = f.y; }
                else { const unsigned u = *(const unsigned*)(UP + (size_t)(MP + bq * 4 + j - 15) * 512 + cg); z0[q] = bflo(u); z1[q] = bfhi(u); } }
            float s0 = 0.f, s1 = 0.f;
#pragma unroll
            for (int q = 0; q < W - 1; ++q) { s0 += z0[q]; s1 += z1[q]; }
#pragma unroll
            for (int t = 0; t < 4; ++t) { s0 += z0[W - 1 + t]; s1 += z1[W - 1 + t];
                *(LAS unsigned*)(dl + (bb * 4 + t) * PD_STRIDE + cl * 2) = pk2(s0 * (1.0f / W) - z0[W - 1 + t], s1 * (1.0f / W) - z1[W - 1 + t]); s0 -= z0[t]; s1 -= z1[t]; }
        }
    }
}
DI void pool_item(int item, int nt_lo, int nt_hi, LAS unsigned char* dl, const bf16_t* UP, const float* spool, const bf16_t* WPT, const float* pscale, bf16_t* CAT, int lane) {
    asm volatile("" : "+v"(lane));
    const int g = item & 3, blk = item >> 2, row0 = blk * 32, r32 = lane & 31, hi = lane >> 5;
    if (g == 0) pool_fill<2>(row0, g, dl, UP, spool, lane); else if (g == 1) pool_fill<4>(row0, g, dl, UP, spool, lane);
    else if (g == 2) pool_fill<8>(row0, g, dl, UP, spool, lane); else pool_fill<16>(row0, g, dl, UP, spool, lane);
    asm volatile("s_waitcnt lgkmcnt(0)" ::: "memory");
    f32x16 acc[4] = {{}, {}, {}, {}};
    if (nt_hi - nt_lo == 4) {
        bf16x8 wb[8][4];
#pragma unroll
        for (int s = 0; s < 8; ++s)
#pragma unroll
            for (int nt = 0; nt < 4; ++nt) wb[s][nt] = *(const bf16x8*)(WPT + ((size_t)g * 128 + 32 * nt + r32) * 128 + 16 * s + 8 * hi);
#pragma unroll
        for (int s = 0; s < 8; ++s) { const bf16x8 af = *(const LAS bf16x8*)(dl + r32 * PD_STRIDE + (16 * s + 8 * hi) * 2);
#pragma unroll
            for (int nt = 0; nt < 4; ++nt) acc[nt] = MFMA32(af, wb[s][nt], acc[nt]); }
    } else {
        bf16x8 wb[8];
#pragma unroll
        for (int s = 0; s < 8; ++s) wb[s] = *(const bf16x8*)(WPT + ((size_t)g * 128 + 32 * nt_lo + r32) * 128 + 16 * s + 8 * hi);
        f32x16 a1 = {};
#pragma unroll
        for (int s = 0; s < 8; ++s) { const bf16x8 af = *(const LAS bf16x8*)(dl + r32 * PD_STRIDE + (16 * s + 8 * hi) * 2); a1 = MFMA32(af, wb[s], a1); }
#pragma unroll
        for (int nt = 0; nt < 4; ++nt) if (nt == nt_lo) acc[nt] = a1;
    }
#pragma unroll
    for (int nt = 0; nt < 4; ++nt) if (nt >= nt_lo && nt < nt_hi) { const float scl = pscale[g * 128 + 32 * nt + r32];
#pragma unroll
        for (int r = 0; r < 16; ++r) CAT[(size_t)(row0 + crow(r, hi)) * DM + 512 + g * 128 + 32 * nt + r32] = f2bf(acc[nt][r] * scl); }
    asm volatile("s_waitcnt lgkmcnt(0)" ::: "memory");
}

DI void mix0_phase(const KA& a, LAS unsigned char* lds, int tid, int bid, int gw, int NGW, int wave, int lane) {
    unsigned char* ws = a.ws();
    const bf16_t *Q = (const bf16_t*)(ws + WS_Q), *Kb = (const bf16_t*)(ws + WS_K), *Vb = (const bf16_t*)(ws + WS_V), *UP = (const bf16_t*)(ws + WS_UP);
    bf16_t* CAT = (bf16_t*)(ws + WS_CAT); const float* biasT = (const float*)(ws + WS_BIAS);
#ifndef MIXM
#define MIXM 15
#endif
    if (MIXM & 1) for (int it = bid; it < 256; it += GRID) attn_prompt_item(it, tid, lds, Q, Kb, Vb, CAT, biasT, a.in(13));
    if (MIXM & 2) for (int it = bid; it < 256; it += GRID) attn_sample_item(it, tid, lds, Q, Kb, Vb, a.in(2), a.in(3), CAT, biasT, a.in(13));
    if (MIXM & 4) { pool_item(gw, 0, 4, lds + wave * PD_BYTES, UP, a.in(4), (const bf16_t*)(ws + WS_WPT), a.in(15), CAT, lane);
        if (wave == 1) pool_item(2048 + (bid >> 2), bid & 3, (bid & 3) + 1, lds + wave * PD_BYTES, UP, a.in(4), (const bf16_t*)(ws + WS_WPT), a.in(15), CAT, lane); }
    if (!(MIXM & 8)) return;
    asm volatile("" : "+v"(lane));
    float* out = a.out(); const int gt = gw * 64 + lane; constexpr int NGT = GRID * 512;
    auto ld4 = [](const bf16_t* p) { const u32x2 w = *(const u32x2*)p; return (f32x4){bflo(w.x), bfhi(w.x), bflo(w.y), bfhi(w.y)}; };
    for (int i4 = gt; i4 < 128 * 4 * 32; i4 += NGT) { const int c = (i4 & 31) * 4, t = (i4 >> 5) & 3, b = i4 >> 7; const size_t r = (size_t)(MP + b * 4 + t) * 128 + c, o = (size_t)(b * 128 + 124 + t) * 128 + c;
        *(f32x4*)(out + O_KS + o) = ld4(Kb + r); *(f32x4*)(out + O_VS + o) = ld4(Vb + r); }
    for (int i4 = gt; i4 < 128 * 4 * 128; i4 += NGT) { const int c = (i4 & 127) * 4, t = (i4 >> 7) & 3, b = i4 >> 9;
        *(f32x4*)(out + O_PS + (size_t)(b * 15 + 11 + t) * 512 + c) = ld4(UP + (size_t)(MP + b * 4 + t) * 512 + c); }
    for (int i4 = gt; i4 < 8 * 128 * 32; i4 += NGT) { const int i = i4 * 4, c = i & 127, w = (i >> 7) & 127, b = i >> 14; const size_t r = (size_t)(b * SEQ + 1920 + w) * 128 + c;
        *(f32x4*)(out + O_KP + i) = ld4(Kb + r); *(f32x4*)(out + O_VP + i) = ld4(Vb + r); }
    for (int i4 = gt; i4 < 8 * 15 * 128; i4 += NGT) { const int i = i4 * 4, c = i & 511, q = i >> 9, ii = q % 15, b = q / 15;
        *(f32x4*)(out + O_PP + i) = ld4(UP + (size_t)(b * SEQ + 2033 + ii) * 512 + c); }
}

constexpr int VN_STRIDE = 528, VN_BYTES = 128 * VN_STRIDE;
DI void sgu_phase(const KA& a, LAS unsigned char* lds, int tid, int bid, int gw, int NGW, int wave, int lane) {
    unsigned char* ws = a.ws(); const int r32 = lane & 31, hi = lane >> 5;
    bf16_t* U = (bf16_t*)(ws + WS_U); const bf16_t* V1 = (const bf16_t*)(ws + WS_V1); const float* sspv = (const float*)(ws + WS_SSP + 5 * SZ_SSP);
    const float* gv = a.in(17); const float* bsp = a.in(19); const bf16_t* WST = (const bf16_t*)(ws + WS_WST);
    LAS float* rsv = (LAS float*)(lds + VN_BYTES);
    for (int item = bid; item < 512; item += GRID) {
        const int ch = item >> 2, g = item & 3, row0 = ch * 128;
        if (tid < 128) { float pp[16];
#pragma unroll
            for (int p = 0; p < 16; ++p) pp[p] = sspv[(size_t)p * MROWS + row0 + tid];
            float s = 0.f;
#pragma unroll
            for (int p = 0; p < 16; ++p) s += pp[p];
            rsv[tid] = rsqrtf(s * (1.0f / 1024.0f) + EPS); }
        __syncthreads();
        { const int c8 = tid & 31, s0 = tid >> 5;
            const f32x4 g0 = *(const f32x4*)(gv + g * 256 + c8 * 8), g1 = *(const f32x4*)(gv + g * 256 + c8 * 8 + 4);
            u32x4 vv[8];
#pragma unroll
            for (int k = 0; k < 8; ++k) vv[k] = *(const u32x4*)(V1 + (size_t)(row0 + s0 + 16 * k) * DM + g * 256 + c8 * 8);
#pragma unroll
            for (int k = 0; k < 8; ++k) { const u32x4 v = vv[k]; const int s = s0 + 16 * k; const float r = rsv[s];
                u32x4 o; o.x = pk2(bflo(v.x) * r * g0[0], bfhi(v.x) * r * g0[1]); o.y = pk2(bflo(v.y) * r * g0[2], bfhi(v.y) * r * g0[3]);
                o.z = pk2(bflo(v.z) * r * g1[0], bfhi(v.z) * r * g1[1]); o.w = pk2(bflo(v.w) * r * g1[2], bfhi(v.w) * r * g1[3]);
                *(LAS u32x4*)(lds + s * VN_STRIDE + c8 * 16) = o; } }
        bf16x8 wa[4][8];
#pragma unroll
        for (int tt = 0; tt < 4; ++tt)
#pragma unroll
            for (int ks = 0; ks < 8; ++ks) if (16 * ks <= 32 * tt + 31) wa[tt][ks] = *(const bf16x8*)(WST + ((size_t)g * 128 + 32 * tt + r32) * 128 + 16 * ks + 8 * hi);
        __syncthreads();
        f32x16 acc[4] = {{}, {}, {}, {}};
#pragma unroll
        for (int ks = 0; ks < 8; ++ks) {
            bf16x8 bfg;
#pragma unroll
            for (int jj = 0; jj < 8; ++jj) bfg[jj] = *(const LAS short*)(lds + (16 * ks + 8 * hi + jj) * VN_STRIDE + (32 * wave + r32) * 2);
#pragma unroll
            for (int tt = 0; tt < 4; ++tt) if (16 * ks <= 32 * tt + 31) acc[tt] = MFMA32(wa[tt][ks], bfg, acc[tt]);
        }
#pragma unroll
        for (int tt = 0; tt < 4; ++tt)
#pragma unroll
            for (int r = 0; r < 16; ++r) { const int t = 32 * tt + crow(r, hi); const size_t idx = (size_t)(row0 + t) * DM + g * 256 + 32 * wave + r32;
                acc[tt][r] = bf2f(U[idx]) * (acc[tt][r] + bsp[g * 128 + t]); }
#pragma unroll
        for (int tt = 0; tt < 4; ++tt)
#pragma unroll
            for (int r = 0; r < 16; ++r) { const int t = 32 * tt + crow(r, hi); const size_t idx = (size_t)(row0 + t) * DM + g * 256 + 32 * wave + r32;
                U[idx] = f2bf(acc[tt][r]); }
        __syncthreads();
    }
    const float* wsp = a.in(18); float* osv = a.out() + O_SV;
    for (int b = bid; b < DBATCH; b += GRID) {
        float rst[4];
#pragma unroll
        for (int s = 0; s < 4; ++s) { float q = (lane < 16) ? sspv[(size_t)lane * MROWS + MP + b * 4 + s] : 0.f; q = wave_sum(q); rst[s] = rsqrtf(q * (1.0f / 1024.0f) + EPS); }
        for (int cc = 2 * wave; cc < 2 * wave + 2; ++cc) { const int c = cc * 64 + lane, g = c >> 8; const float gc = gv[c]; float vn[4], uu[4], bb[4], ww[4][4];
#pragma unroll
            for (int s = 0; s < 4; ++s) { vn[s] = bf2f(V1[(size_t)(MP + b * 4 + s) * DM + c]); uu[s] = bf2f(U[(size_t)(MP + b * 4 + s) * DM + c]); bb[s] = bsp[g * 128 + s];
#pragma unroll
                for (int t = 0; t < 4; ++t) ww[t][s] = (s <= t) ? wsp[((size_t)g * 128 + t) * 128 + s] : 0.f; }
#pragma unroll
            for (int s = 0; s < 4; ++s) vn[s] = vn[s] * rst[s] * gc;
#pragma unroll
            for (int s = 0; s < 4; ++s) osv[(size_t)(b * 4 + s) * DM + c] = vn[s];
#pragma unroll
            for (int t = 0; t < 4; ++t) { float mx = bb[t];
#pragma unroll
                for (int s = 0; s < 4; ++s) if (s <= t) mx += ww[t][s] * vn[s];
                U[(size_t)(MP + b * 4 + t) * DM + c] = f2bf(uu[t] * mx); } }
    }
}

DI void final_phase(const KA& a, int gw, int NGW, int lane) {
    const float* fg = a.in(7); const bf16_t* XB = (const bf16_t*)(a.ws() + WS_XB); float* out = a.out();
    auto ld = [&](int m, u32x4 (&x)[2]) { const u32x4* xr = (const u32x4*)(XB + (size_t)m * DM) + lane; x[0] = xr[0]; x[1] = xr[64]; };
    auto fin = [&](int m, const u32x4 (&x)[2]) { f32x4 v[4]; float s = 0.f;
#pragma unroll
        for (int j = 0; j < 2; ++j) { v[2 * j] = (f32x4){bflo(x[j].x), bfhi(x[j].x), bflo(x[j].y), bfhi(x[j].y)}; v[2 * j + 1] = (f32x4){bflo(x[j].z), bfhi(x[j].z), bflo(x[j].w), bfhi(x[j].w)}; }
#pragma unroll
        for (int j = 0; j < 4; ++j) s += (v[j].x * v[j].x + v[j].y * v[j].y) + (v[j].z * v[j].z + v[j].w * v[j].w);
        const float r = rsqrtf(wave_sum(s) * (1.0f / DM) + EPS);
#pragma unroll
        for (int j = 0; j < 4; ++j) { const int e = (j >> 1) * 512 + lane * 8 + (j & 1) * 4; const f32x4 gg = *(const f32x4*)(fg + e); *(f32x4*)(out + (size_t)m * DM + e) = v[j] * r * gg; } };
    u32x4 x0[2], x1[2], x2[2], x3[2];
#pragma unroll 1
    for (int m = gw; m < MROWS; m += 4 * NGW) {
        const bool h1 = m + NGW < MROWS, h2 = m + 2 * NGW < MROWS, h3 = m + 3 * NGW < MROWS;
        ld(m, x0); if (h1) ld(m + NGW, x1); if (h2) ld(m + 2 * NGW, x2); if (h3) ld(m + 3 * NGW, x3);
        fin(m, x0); if (h1) fin(m + NGW, x1); if (h2) fin(m + 2 * NGW, x2); if (h3) fin(m + 3 * NGW, x3);
    }
}

struct SideResid {
    const float* in; bf16_t* XB; float* ssp; float s;
    float* Y; const float* gain; float* xs; unsigned* cnt;
    DI void pre(int, int, LAS float*) const {}
    DI void operator()(f32x4 acc, int row, int col, int cb, int lr, int tid, const LAS float*) const {
        const size_t off = (size_t)row * DM + col;
        f32x4 a; if (in) a = *(const f32x4*)(in + off); else { const u32x2 x = *(const u32x2*)(XB + off); a = (f32x4){bflo(x.x), bfhi(x.x), bflo(x.y), bfhi(x.y)}; }
        a = a + acc * s;
        if (Y) {
            float q = (a[0] * a[0] + a[1] * a[1]) + (a[2] * a[2] + a[3] * a[3]);
            q += __shfl_xor(q, 1); q += __shfl_xor(q, 2); q += __shfl_xor(q, 4); q += __shfl_xor(q, 8);
            float* slot = xs + (size_t)(row - MP) * 16; unsigned* c = cnt + 64 * ((row - MP) >> 5);
            if ((tid & 15) == 0) st4_wt(slot + cb, q);
            asm volatile("s_waitcnt vmcnt(0)" ::: "memory"); __syncthreads();
            if (tid == 0) { __hip_atomic_fetch_add(c, 1u, __ATOMIC_RELAXED, __HIP_MEMORY_SCOPE_AGENT); wait_count(c, 16u); }
            __syncthreads();
            const f32x4 p0 = *(const f32x4*)(slot), p1 = *(const f32x4*)(slot + 4), p2 = *(const f32x4*)(slot + 8), p3 = *(const f32x4*)(slot + 12);
            const float tot = ((p0[0] + p0[1]) + (p0[2] + p0[3])) + ((p1[0] + p1[1]) + (p1[2] + p1[3])) + ((p2[0] + p2[1]) + (p2[2] + p2[3])) + ((p3[0] + p3[1]) + (p3[2] + p3[3]));
            *(f32x4*)(Y + off) = a * rsqrtf(tot * (1.0f / DM) + EPS) * *(const f32x4*)(gain + col);
            return;
        }
        u32x2 w; w.x = pk2(a[0], a[1]); w.y = pk2(a[2], a[3]); *(u32x2*)(XB + off) = w;
        float q = (a[0] * a[0] + a[1] * a[1]) + (a[2] * a[2] + a[3] * a[3]);
        q += __shfl_xor(q, 1); q += __shfl_xor(q, 2); q += __shfl_xor(q, 4); q += __shfl_xor(q, 8);
        if ((tid & 15) == 0) ssp[(size_t)cb * MROWS + row] = q;
    }
};
struct SideGeluUV {
    const float* ssp_in; bf16_t *U, *V1; float* ssp;
    DI void pre(int row0, int tid, LAS float* rl) const { if (tid < 32) { float pp[16];
#pragma unroll
            for (int p = 0; p < 16; ++p) pp[p] = ssp_in[(size_t)p * MROWS + row0 + tid];
            float s = 0.f;
#pragma unroll
            for (int p = 0; p < 16; ++p) s += pp[p];
            rl[tid] = rsqrtf(s * (1.0f / DM) + EPS); } }
    DI void operator()(f32x4 acc, int row, int col, int cb, int lr, int tid, const LAS float* rl) const {
        const float r = rl[lr]; f32x4 v; float q = 0.f;
#pragma unroll
        for (int i = 0; i < 4; ++i) { v[i] = gelu_tanh(acc[i] * r); q += v[i] * v[i]; }
        u32x2 w; w.x = pk2(v[0], v[1]); w.y = pk2(v[2], v[3]);
        if (col < 1024) *(u32x2*)(U + (size_t)row * DM + col) = w;
        else { *(u32x2*)(V1 + (size_t)row * DM + col - 1024) = w;
            q += __shfl_xor(q, 1); q += __shfl_xor(q, 2); q += __shfl_xor(q, 4); q += __shfl_xor(q, 8);
            if ((tid & 15) == 0) ssp[(size_t)(cb - 16) * MROWS + row] = q; }
    }
};
constexpr int SG_STRIDE = 528, SG_STAGE = 96 * SG_STRIDE;
template <class SEpi> DI void side_gemm(LAS unsigned char* lds, int tid, int bid, const bf16_t* A, const bf16_t* Bt, int N, int K, const SEpi& E) {
    asm volatile("" : "+v"(tid));
    const int lane = tid & 63, wid = __builtin_amdgcn_readfirstlane(tid >> 6), r32 = lane & 31, hi = lane >> 5;
    const int ncb = N >> 6, npieces = 16 * ncb, nc = K >> 8;
    LAS float* part = (LAS float*)lds + wid * 2048; LAS float* rl = (LAS float*)(lds + 2 * SG_STAGE);
#pragma unroll 1
    for (int p = bid; p < npieces; p += GRID) {
        const int cb = p % ncb, rb = p / ncb, row0 = MP + rb * 32, col0 = cb * 64;
        E.pre(row0, tid, rl);
        const bf16_t* src[6]; int dst[6];
#pragma unroll
        for (int i = 0; i < 6; ++i) { const int u = tid + 512 * i, row = u >> 5, c16 = u & 31;
            src[i] = (row < 32 ? A + (size_t)(row0 + row) * K : Bt + (size_t)(col0 + row - 32) * K) + c16 * 8; dst[i] = row * SG_STRIDE + c16 * 16; }
        u32x4 ra[6], rb2[6];
#define SG_LOAD(R, ch) do { _Pragma("unroll") for (int i = 0; i < 6; ++i) R[i] = *(const u32x4*)(src[i] + (ch) * 256); } while (0)
#define SG_WRITE(R, st) do { _Pragma("unroll") for (int i = 0; i < 6; ++i) *(LAS u32x4*)(lds + (st) * SG_STAGE + dst[i]) = R[i]; } while (0)
#define SG_COMP(st) do { _Pragma("unroll") for (int s2 = 0; s2 < 2; ++s2) { const int koff = (16 * (2 * wid + s2) + 8 * hi) * 2; const LAS unsigned char* sp_ = lds + (st) * SG_STAGE; \
            const bf16x8 a = *(const LAS bf16x8*)(sp_ + r32 * SG_STRIDE + koff), x0 = *(const LAS bf16x8*)(sp_ + (32 + r32) * SG_STRIDE + koff), x1 = *(const LAS bf16x8*)(sp_ + (64 + r32) * SG_STRIDE + koff); \
            c0 = MFMA32(a, x0, c0); c1 = MFMA32(a, x1, c1); } } while (0)
        SG_LOAD(ra, 0); SG_LOAD(rb2, 1);
        SG_WRITE(ra, 0);
        __syncthreads();
        f32x16 c0 = {}, c1 = {};
#pragma unroll 1
        for (int kc = 0; kc < nc; kc += 2) {
            if (kc + 2 < nc) SG_LOAD(ra, kc + 2);
            SG_COMP(0);
            if (kc + 1 < nc) SG_WRITE(rb2, 1);
            __syncthreads();
            if (kc + 1 >= nc) break;
            if (kc + 3 < nc) SG_LOAD(rb2, kc + 3);
            SG_COMP(1);
            if (kc + 2 < nc) SG_WRITE(ra, 0);
            __syncthreads();
        }
#undef SG_LOAD
#undef SG_WRITE
#undef SG_COMP
#pragma unroll
        for (int r = 0; r < 16; ++r) { part[crow(r, hi) * 64 + r32] = c0[r]; part[crow(r, hi) * 64 + 32 + r32] = c1[r]; }
        __syncthreads();
        const int lr = tid >> 4, c4 = (tid & 15) * 4; f32x4 s = {0.f, 0.f, 0.f, 0.f};
#pragma unroll
        for (int w = 0; w < 8; ++w) s = s + *(const LAS f32x4*)((LAS float*)lds + w * 2048 + lr * 64 + c4);
        E(s, row0 + lr, col0 + c4, cb, lr, tid, rl);
        __syncthreads();
    }
}

constexpr int NPHASE = 15;
template <class Epi, bool STRIP = false> DI void run_gemm(LAS unsigned char* lds, const int tid, const int bid, int M, const bf16_t* A, const bf16_t* Bt, int N, int K, const float* ssp, const Epi& E) {
    pg8::Gemm g{A, Bt, M, N, K}; pg8::Order S; S.init(M, N, GRID, bid); S.ssp = ssp; S.rs = (LAS float*)(lds + RS_OFF);
    pg8::gemm_phase<Epi, pg8::Order, true, true, STRIP>(lds, g, S, E, tid);
}

__global__ void __launch_bounds__(512, 2) mk_fwd(Args args) {
    extern __shared__ __attribute__((aligned(16))) unsigned char lds_raw[];
    LAS unsigned char* lds0 = (LAS unsigned char*)lds_raw;
    constexpr int NGW = GRID * 8;
    unsigned* ctl = (unsigned*)(args.ws + WS_CTL);
    volatile LAS unsigned* MISC = (volatile LAS unsigned*)(lds0 + MISC_OFF);
    for (int u = threadIdx.x; u < 256; u += 512) ((LAS unsigned*)(lds0 + MISC_OFF))[u] = 0u;
    __syncthreads();
    XcdBarrier bar; bar.bar = ctl + CW_BAR; bar.x = 0; bar.st = nullptr;
    if (!MK_PER_PHASE) bar = xcd_barrier_post(ctl + CW_BAR, MISC + 8);
    const int lo = args.ph_lo, hi = args.ph_hi;
#if defined(REP_PH)
    int rep_left = 1;
#endif
#pragma unroll 1
    for (int ph = lo; ph < hi; ++ph) {
        int tid = threadIdx.x; asm volatile("" : "+v"(tid));
        const int lane = tid & 63, wave = __builtin_amdgcn_readfirstlane(tid >> 6);
        LAS unsigned char* lds = lds0; asm volatile("" : "+s"(lds));
        int bid = blockIdx.x; asm volatile("" : "+s"(bid)); const int gw = bid * 8 + wave;
        bar.st = (volatile LAS unsigned*)(lds + MISC_OFF) + 8;
        KA ka; ka.kp = (const CAS char*)__builtin_amdgcn_kernarg_segment_ptr(); asm volatile("" : "+s"(ka.kp));
        unsigned char* ws = ka.ws(); float* X = ka.out(); bf16_t* XB = (bf16_t*)(ws + WS_XB); bf16_t* ACT = (bf16_t*)(ws + WS_ACT);
        if (ph == 0 && (PHM & 1)) prologue(ka, lds, gw, NGW, wave, lane);
        else if ((ph == 1 || ph == 6 || ph == 8 || ph == 13) && (PHM & 2)) {
            const int lh = ph == 1 ? 0 : ph == 6 ? 1 : ph == 8 ? 2 : 3, si = ph == 1 ? 0 : ph == 6 ? 2 : ph == 8 ? 3 : 6;
            run_gemm(lds, tid, bid, MROWS, XB, (const bf16_t*)(ws + WS_WGU + (size_t)lh * SZ_WGU), NGU, DM, (const float*)(ws + WS_SSP + (size_t)si * SZ_SSP), EpiSwiGLU{ACT});
            if ((ph == 1 || ph == 6) && bid >= 172) convert_set(ka, lds, ph == 1 ? 1 : 3, (bid - 172) * 8 + wave, 84 * 8, wave, lane);
            if (ph == 8 && bid >= 172) state_copies(ka, (bid - 172) * 512 + tid, 84 * 512);
        } else if ((ph == 2 || ph == 7 || ph == 9 || ph == 14 || ph == 5 || ph == 12) && (PHM & 4)) {
            const bool isd = !(ph == 5 || ph == 12);
            const int lh = ph == 2 ? 0 : ph == 7 ? 1 : ph == 9 ? 2 : 3;
            const int so = ph == 2 ? 1 : ph == 5 ? 2 : ph == 7 ? 3 : ph == 9 ? 4 : ph == 12 ? 6 : 7;
            const bf16_t* A = isd ? ACT : (ph == 5 ? (const bf16_t*)(ws + WS_CAT) : (const bf16_t*)(ws + WS_U));
            const bf16_t* Bt = isd ? (const bf16_t*)(ws + WS_WD + (size_t)lh * SZ_WD) : (ph == 5 ? (const bf16_t*)(ws + WS_WOUT0) : (const bf16_t*)(ws + WS_WOUT1));
            const float* ilo = nullptr; const float* ihi = nullptr;
            float* sspo = (float*)(ws + WS_SSP + (size_t)so * SZ_SSP);
            const bool fin = ph == 14; float* fx = (float*)(ws + WS_SSP + 7 * SZ_SSP); unsigned* fc = (unsigned*)(ws + WS_CTL) + CW_FIN;
            if (fin) { run_gemm(lds, tid, bid, MP, A, Bt, DM, FF, nullptr, EpiFinal{XB, 0.5f, X, ka.in(7), fx, fc});
                side_gemm(lds, tid, bid, A, Bt, DM, FF, SideResid{ihi, XB, sspo, 0.5f, X, ka.in(7), fx + (size_t)MP * 4, fc + 64 * 64}); }
            else run_gemm<EpiResid, true>(lds, tid, bid, MP, A, Bt, DM, isd ? FF : DM, nullptr, EpiResid{ilo, ihi, XB, sspo, isd ? 0.5f : 1.0f});
        } else if (ph == 3 && (PHM & 8)) { run_gemm(lds, tid, bid, MROWS, XB, (const bf16_t*)(ws + WS_WIN0), NIN0, DM, (const float*)(ws + WS_SSP + 1 * SZ_SSP), EpiProj0{(bf16_t*)(ws + WS_Q), (bf16_t*)(ws + WS_K), (bf16_t*)(ws + WS_V), (bf16_t*)(ws + WS_UP)});
            if (bid >= 74) convert_set(ka, lds, 2, (bid - 74) * 8 + wave, 182 * 8, wave, lane); }
        else if (ph == 4 && (PHM & 16)) mix0_phase(ka, lds, tid, bid, gw, NGW, wave, lane);
        else if (ph == 10 && (PHM & 32)) { const float* sspi = (const float*)(ws + WS_SSP + 4 * SZ_SSP); float* sspo = (float*)(ws + WS_SSP + 5 * SZ_SSP);
            run_gemm(lds, tid, bid, MP, XB, (const bf16_t*)(ws + WS_WIN1), NIN1, DM, sspi, EpiGeluUV{(bf16_t*)(ws + WS_U), (bf16_t*)(ws + WS_V1), sspo});
            side_gemm(lds, tid, bid, XB, (const bf16_t*)(ws + WS_WIN1), NIN1, DM, SideGeluUV{sspi, (bf16_t*)(ws + WS_U), (bf16_t*)(ws + WS_V1), sspo}); }
        else if (ph == 11 && (PHM & 64)) sgu_phase(ka, lds, tid, bid, gw, NGW, wave, lane);
        else if (ph == 15 && (PHM & 128)) final_phase(ka, gw, NGW, lane);
#if defined(REP_PH)
        if (ph == REP_PH && rep_left > 0) { --rep_left; --ph; xcd_barrier(bar); continue; }
#endif
        if (ph + 1 < hi) xcd_barrier(bar);
    }
}

extern "C" void kernel_launch(void* const* d_in, const int* in_sizes, int n_in, void* d_out, int out_size, void* d_ws, size_t ws_size, hipStream_t stream) {
    static int grid = 0;
    if (grid == 0) {
        if (n_in != 21 || (size_t)out_size != O_END || ws_size < WS_END) { fprintf(stderr, "kernel_launch: unexpected shapes (n_in %d out %d ws %zu)\n", n_in, out_size, ws_size); grid = -1; return; }
        int dev = 0, cus = 0, per_cu = 0;
        if (hipGetDevice(&dev) != hipSuccess || hipDeviceGetAttribute(&cus, hipDeviceAttributeMultiprocessorCount, dev) != hipSuccess) { grid = -1; return; }
        if (hipFuncSetAttribute((const void*)mk_fwd, hipFuncAttributeMaxDynamicSharedMemorySize, LDS_BYTES) != hipSuccess) { fprintf(stderr, "kernel_launch: hipFuncSetAttribute failed\n"); grid = -1; return; }
        if (hipOccupancyMaxActiveBlocksPerMultiprocessor(&per_cu, (const void*)mk_fwd, 512, LDS_BYTES) != hipSuccess || per_cu < 1) { fprintf(stderr, "kernel_launch: occupancy query reports %d\n", per_cu); }
        (void)hipGetLastError();
        if (cus < GRID) fprintf(stderr, "kernel_launch: %d CUs < %d: the grid cannot be resident\n", cus, GRID);
        grid = GRID;
    }
    if (grid < 0) return;
    (void)hipMemsetAsync((char*)d_ws + WS_CTL + (size_t)CW_BAR * 4, 0, (size_t)(CW_FIN + 80 * 64 - CW_BAR) * 4, stream);
    Args a{};
    for (int i = 0; i < 21; ++i) a.in[i] = (const float*)d_in[i];
    a.out = (float*)d_out; a.ws = (unsigned char*)d_ws;
#if MK_PER_PHASE
    for (int p = 0; p < NPHASE; ++p) { a.ph_lo = p; a.ph_hi = p + 1; hipLaunchKernelGGL(mk_fwd, dim3(grid), dim3(512), LDS_BYTES, stream, a); }
#else
    a.ph_lo = 0; a.ph_hi = NPHASE;
    hipLaunchKernelGGL(mk_fwd, dim3(grid), dim3(512), LDS_BYTES, stream, a);
#endif
}
```

```cpp
#include <hip/hip_runtime.h>
#include <cstdio>
#include <cstdint>

#define LAS __attribute__((address_space(3)))
#define GAS __attribute__((address_space(1)))
#define DI __device__ __forceinline__
typedef unsigned short bf16_t;
typedef short bf16x8 __attribute__((ext_vector_type(8)));
typedef float f32x4 __attribute__((ext_vector_type(4)));
typedef float f32x2 __attribute__((ext_vector_type(2)));
typedef float f32x16 __attribute__((ext_vector_type(16)));
typedef unsigned u32x4 __attribute__((ext_vector_type(4)));
typedef unsigned u32x2 __attribute__((ext_vector_type(2)));
typedef __bf16 bf16x2_t __attribute__((ext_vector_type(2)));

#ifndef PHM
#define PHM 0xffff
#endif
#ifndef MK_PER_PHASE
#define MK_PER_PHASE 0
#endif

constexpr int DM = 1024, NBATCH = 8, SEQ = 2048, DBATCH = 128, DSEQ = 4;
constexpr int MP = NBATCH * SEQ, MS = DBATCH * DSEQ, MROWS = MP + MS;
constexpr int FF = 2816, NGU = 2 * FF, NIN0 = 1280, NIN1 = 2048;
constexpr float EPS = 1e-6f, NEGV = -1e30f, LOG2E = 1.4426950408889634f;

constexpr size_t WS_CTL = 0, CTL_BYTES = 1u << 20;
constexpr size_t SZ_WGU = (size_t)NGU * DM * 2, SZ_WD = (size_t)DM * FF * 2;
constexpr size_t WS_WGU = CTL_BYTES;
constexpr size_t WS_WD = WS_WGU + 4 * SZ_WGU;
constexpr size_t WS_WIN0 = WS_WD + 4 * SZ_WD;
constexpr size_t WS_WOUT0 = WS_WIN0 + (size_t)NIN0 * DM * 2;
constexpr size_t WS_WIN1 = WS_WOUT0 + (size_t)DM * DM * 2;
constexpr size_t WS_WOUT1 = WS_WIN1 + (size_t)NIN1 * DM * 2;
constexpr size_t WS_WPT = WS_WOUT1 + (size_t)DM * DM * 2;
constexpr size_t WS_WST = WS_WPT + 4 * 128 * 128 * 2;
constexpr size_t WS_BIAS = WS_WST + 4 * 128 * 128 * 2;
constexpr size_t SZ_SSP = (size_t)16 * MROWS * 4;
constexpr size_t WS_SSP = WS_BIAS + 8 * 128 * 4;
constexpr size_t WS_XB = WS_SSP + 8 * SZ_SSP;
constexpr size_t WS_ACT = WS_XB + (size_t)MROWS * DM * 2;
constexpr size_t WS_END = WS_ACT + (size_t)MROWS * FF * 2;
constexpr size_t WS_Q = WS_ACT, WS_K = WS_Q + (size_t)MROWS * 512 * 2, WS_V = WS_K + (size_t)MROWS * 128 * 2, WS_UP = WS_V + (size_t)MROWS * 128 * 2, WS_CAT = WS_UP + (size_t)MROWS * 512 * 2;
constexpr size_t WS_U = WS_ACT, WS_V1 = WS_U + (size_t)MROWS * 1024 * 2;
static_assert(WS_CAT + (size_t)MROWS * 1024 * 2 <= WS_END && WS_V1 + (size_t)MROWS * 1024 * 2 <= WS_END && WS_END <= 268435456, "d_ws map");

constexpr size_t O_Y = 0, O_KP = (size_t)MROWS * DM, O_VP = O_KP + 8 * 128 * 128, O_PP = O_VP + 8 * 128 * 128, O_KS = O_PP + 8 * 15 * 512,
                 O_VS = O_KS + (size_t)128 * 128 * 128, O_PS = O_VS + (size_t)128 * 128 * 128, O_SV = O_PS + (size_t)128 * 15 * 512, O_END = O_SV + (size_t)128 * 4 * 1024;

constexpr int CW_BAR = 4096, CW_FIN = 7680;
constexpr int GRID = 256;
constexpr int RING_BYTES = 131072, MISC_OFF = RING_BYTES, RS_OFF = RING_BYTES + 1024, LDS_BYTES = 147456;

DI unsigned pk2(float lo, float hi) { f32x2 v = {lo, hi}; bf16x2_t b = __builtin_convertvector(v, bf16x2_t); return __builtin_bit_cast(unsigned, b); }
DI float bflo(unsigned w) { return __uint_as_float(w << 16); }
DI float bfhi(unsigned w) { return __uint_as_float(w & 0xffff0000u); }
DI float bf2f(bf16_t b) { return __uint_as_float((unsigned)b << 16); }
DI bf16_t f2bf(float f) { return (bf16_t)(pk2(f, 0.f) & 0xffffu); }
typedef __amdgpu_buffer_rsrc_t rsrc_t;
DI rsrc_t mk_rsrc(const void* p) { return __builtin_amdgcn_make_buffer_rsrc((void*)p, 0, 0x7fffffff, 0x00020000); }
DI void bst16(rsrc_t r, unsigned off, u32x4 v) { __builtin_amdgcn_raw_buffer_store_b128(v, r, off, 0, 0); }
DI void bst16w(rsrc_t r, unsigned off, u32x4 v, bool wt) { if (wt) __builtin_amdgcn_raw_buffer_store_b128(v, r, off, 0, 16); else __builtin_amdgcn_raw_buffer_store_b128(v, r, off, 0, 0); }
DI u32x4 bld16(rsrc_t r, unsigned off) { return __builtin_amdgcn_raw_buffer_load_b128(r, off, 0, 0); }
DI void st4_wt(float* p, float v) { asm volatile("global_store_dword %0, %1, off sc1\n\ts_nop 1" :: "v"(p), "v"(v) : "memory"); }
DI void wait_count(unsigned* c, unsigned need) {
    for (unsigned sp = 0; __hip_atomic_load(c, __ATOMIC_RELAXED, __HIP_MEMORY_SCOPE_AGENT) < need && sp < (1u << 18); ++sp) __builtin_amdgcn_s_sleep(2);
    __builtin_amdgcn_fence(__ATOMIC_ACQUIRE, "agent");
    asm volatile("s_waitcnt vmcnt(0)" ::: "memory");
}
DI float fexp(float x) { return __builtin_amdgcn_exp2f(x * LOG2E); }
template <int M> DI float shx(float v) { return __builtin_bit_cast(float, __builtin_amdgcn_ds_swizzle(__builtin_bit_cast(int, v), (M << 10) | 0x1F)); }
DI float add32(float v) { const auto r = __builtin_amdgcn_permlane32_swap(__builtin_bit_cast(unsigned, v), __builtin_bit_cast(unsigned, v), false, false);
    return __builtin_bit_cast(float, (unsigned)r[0]) + __builtin_bit_cast(float, (unsigned)r[1]); }
DI float max32(float v) { const auto r = __builtin_amdgcn_permlane32_swap(__builtin_bit_cast(unsigned, v), __builtin_bit_cast(unsigned, v), false, false);
    return fmaxf(__builtin_bit_cast(float, (unsigned)r[0]), __builtin_bit_cast(float, (unsigned)r[1])); }
DI float wave_sum(float v) {
    v += shx<1>(v); v += shx<2>(v); v += shx<4>(v); v += shx<8>(v); v += shx<16>(v); v = add32(v);
    return v;
}

namespace pg8 {
constexpr int BM = 256, BK = 64, HALF = 128, HTB = HALF * BK * 2, STAGE_BYTES = 8 * HTB, NXCD = 8, WGM = 4;
__host__ __device__ __forceinline__ int lds_byte(int r, int c) { const int st = (r >> 4) * 2 + (c >> 5), rr = r & 15, cc = c & 31, ob = rr * 64 + cc * 2; return st * 1024 + (ob ^ (((ob >> 9) & 1) << 5)); }
__host__ __device__ __forceinline__ void stage_rc(int b, int& R, int& C) { const int st = b / 1024, sb = b % 1024, swz = sb ^ (((sb >> 9) & 1) << 5); R = (st >> 1) * 16 + swz / 64; C = (st & 1) * 32 + (swz % 64) / 2; }
__host__ __device__ __forceinline__ int perm32(int rho) { const int n = rho >> 4, i = rho & 15; return 8 * (i >> 2) + 4 * n + (i & 3); }

struct Unit { int pm, pn; };
struct Gemm { const bf16_t* A; const bf16_t* Bt; int M, N, K; };

struct Order {
    int nM, nN, nwg, G, c;
    int pst = MROWS;
    const float* ssp; LAS float* rs; bool strip = false;
    DI void init(int M, int N, int G_, int c_) { nM = M / BM; nN = N / BM; nwg = nM * nN; G = G_; c = c_; }
    DI bool next(int i, Unit& u) const {
        const long L = (long)i * G + c; if (L >= nwg) return false;
        int wgid = (int)L; { const int q = nwg / NXCD, r = nwg % NXCD, xcd = wgid % NXCD, off = wgid / NXCD; wgid = (xcd < r ? xcd * (q + 1) : r * (q + 1) + (xcd - r) * q) + off; }
        const int nig = WGM * nN, gid = wgid / nig, fm = gid * WGM, gsz = (nM - fm) < WGM ? (nM - fm) : WGM;
        u.pm = fm + ((wgid % nig) % gsz); u.pn = (wgid % nig) / gsz; return true;
    }
    DI void rs_all(int tid) const {
        if (ssp) { const int row = tid >> 1, half = tid & 1; float s[6];
            float pv[6][8];
#pragma unroll
            for (int i = 0; i < 6; ++i) { Unit u; if (!next(i, u)) next(0, u); const float* p = ssp + (size_t)(8 * half) * pst + u.pm * BM + row;
#pragma unroll
                for (int k = 0; k < 8; ++k) pv[i][k] = p[(size_t)k * pst]; }
#pragma unroll
            for (int i = 0; i < 6; ++i) s[i] = ((pv[i][0] + pv[i][1]) + (pv[i][2] + pv[i][3])) + ((pv[i][4] + pv[i][5]) + (pv[i][6] + pv[i][7]));
#pragma unroll
            for (int i = 0; i < 6; ++i) { float t = s[i]; t += shx<1>(t); if (!half) rs[i * 256 + row] = rsqrtf(t * (1.0f / DM) + EPS); }
            if (strip && tid < 32) { Unit u; if (!next(tid >> 4, u)) next(0, u); const float* p = ssp + MP + (u.pm >> 1) * 16 + (tid & 15); float pp[16], t = 0.f;
#pragma unroll
                for (int k = 0; k < 16; ++k) pp[k] = p[(size_t)k * MROWS];
#pragma unroll
                for (int k = 0; k < 16; ++k) t += pp[k];
                rs[1024 + tid] = rsqrtf(t * (1.0f / DM) + EPS); } }
    }
    DI void a_ready(const Unit& u, int slot, int tid) const {
        if (ssp) {
            const int row = tid >> 1, half = tid & 1;
            const float* p = ssp + (size_t)(8 * half) * MROWS + u.pm * BM + row;
            float s = 0.f;
#pragma unroll
            for (int k = 0; k < 8; ++k) s += p[(size_t)k * MROWS];
            s += shx<1>(s);
            if (!half) rs[slot * 256 + row] = rsqrtf(s * (1.0f / DM) + EPS);
        }
    }
};

constexpr int STRIP_OFF = RS_OFF + 6 * 1024;
static_assert(STRIP_OFF + 8192 <= LDS_BYTES && STRIP_OFF % 16 == 0, "strip ring LDS map");
template <class Epi, class Sched, bool ALIGN_EPI, bool SP2, bool STRIP = false>
DI void gemm_phase(LAS unsigned char* lds, const Gemm g, const Sched& S, const Epi& E, const int tid) {
    const int wid = __builtin_amdgcn_readfirstlane(tid >> 6), lane = tid & 63, wr = wid >> 2, wc = wid & 3, fr = lane & 15, fq = lane >> 4;
    const int K = g.K, nt = K / BK;
    unsigned voffA[2], voffB[2];
#pragma unroll
    for (int i = 0; i < 2; ++i) { int R, C; stage_rc(tid * 16 + i * 8192, R, C); const int Rb = (R & ~31) + perm32(R & 31);
        voffA[i] = (unsigned)(R * K + C) * 2u; voffB[i] = (unsigned)(Rb * K + C) * 2u; }
    const size_t kstep = (size_t)(BK * 2);
    const size_t hstep = (size_t)HALF * K * 2;
    const size_t tstep = 2 * hstep;
    const unsigned ldsw = (unsigned)wid * 1024u; const unsigned ldsm0 = (unsigned)(size_t)(lds + ldsw);
    const int aoff = lds_byte(wr * 64 + fr, fq * 8), boff = lds_byte(wc * 32 + fr, fq * 8) + 4 * HTB;
#define PG8_SA(b, h) (((b) * 2 + (h)) * HTB)
#define PG8_SB(b, h) ((4 + (b) * 2 + (h)) * HTB)
#define PG8_STAGE(bufoff, gbase, voff) do { \
        asm volatile("s_add_i32 m0, %1, %3\n\ts_nop 0\n\tglobal_load_lds_dwordx4 %0, %2" :: "v"((voff)[0]), "s"(ldsm0), "s"((const char*)(gbase)), "n"(bufoff) : "memory", "scc"); \
        asm volatile("s_add_i32 m0, %1, %3\n\ts_nop 0\n\tglobal_load_lds_dwordx4 %0, %2" :: "v"((voff)[1]), "s"(ldsm0), "s"((const char*)(gbase)), "n"((bufoff) + 8192) : "memory", "scc"); } while (0)
#define PG8_LDA(dst, b, h) do { _Pragma("unroll") for (int m = 0; m < 4; ++m) _Pragma("unroll") for (int k = 0; k < 2; ++k) dst[m][k] = *(const LAS bf16x8*)(lds + PG8_SA(b, h) + aoff + m * 2048 + k * 1024); } while (0)
#define PG8_LDB(dst, b, h) do { _Pragma("unroll") for (int n = 0; n < 2; ++n) _Pragma("unroll") for (int k = 0; k < 2; ++k) dst[n][k] = *(const LAS bf16x8*)(lds + (PG8_SB(b, h) - 4 * HTB) + boff + n * 2048 + k * 1024); } while (0)
#define PG8_MMA(ai, bj, At, Bt) do { __builtin_amdgcn_s_setprio(1); _Pragma("unroll") for (int m = 0; m < 4; ++m) _Pragma("unroll") for (int n = 0; n < 2; ++n) _Pragma("unroll") for (int k = 0; k < 2; ++k) \
        acc[ai][bj][m][n] = __builtin_amdgcn_mfma_f32_16x16x32_bf16(Bt[n][k], At[m][k], acc[ai][bj][m][n], 0, 0, 0); __builtin_amdgcn_s_setprio(0); } while (0)
#define PG8_WAIT_V(n) asm volatile("s_waitcnt vmcnt(" #n ")" ::: "memory")
#define PG8_WAIT_L(n) asm volatile("s_waitcnt lgkmcnt(" #n ")" ::: "memory")
#define PG8_BAR __builtin_amdgcn_s_barrier()
#define PG8_SCHED __builtin_amdgcn_sched_barrier(0)
    Unit cur, nxt; int ui = 0;
    if (!S.next(0, cur)) return;
    f32x4 acc[2][2][4][2];
#pragma unroll
    for (int a = 0; a < 2; ++a)
#pragma unroll
        for (int b = 0; b < 2; ++b)
#pragma unroll
            for (int m = 0; m < 4; ++m)
#pragma unroll
                for (int n = 0; n < 2; ++n) acc[a][b][m][n] = (f32x4){0.f, 0.f, 0.f, 0.f};
    bf16x8 At[4][2], B0[2][2], B1[2][2];
    const char* cA = (const char*)g.A + (size_t)cur.pm * tstep; const char* cB = (const char*)g.Bt + (size_t)cur.pn * tstep;
    f32x4 accS[2] = {{0.f, 0.f, 0.f, 0.f}, {0.f, 0.f, 0.f, 0.f}}; bf16x8 As; int sp = 0; const char* sA = nullptr;
    const int shi = (wid >> 1) & 1;
#define PG8_SSTG(stg, gsrc) asm volatile("s_mov_b32 m0, %1\n\ts_nop 0\n\tglobal_load_lds_dwordx4 %0, %2" :: "v"(voffA[0]), "s"((unsigned)(size_t)(lds + STRIP_OFF + ((stg) + shi) * 2048 + (wid & 1) * 1024)), \
        "s"((gsrc) + (size_t)shi * kstep - (size_t)((wid >> 1) * 16) * K * 2) : "memory")
#define PG8_LDS(stg, k) As = *(const LAS bf16x8*)(lds + STRIP_OFF + (stg) * 2048 + (aoff - wr * 8192) + (k) * 1024)
#define PG8_SMMA(k) do { __builtin_amdgcn_s_setprio(1); _Pragma("unroll") for (int n = 0; n < 2; ++n) accS[n] = __builtin_amdgcn_mfma_f32_16x16x32_bf16(B0[n][k], As, accS[n], 0, 0, 0); __builtin_amdgcn_s_setprio(0); } while (0)
    u32x4 xS = {0u, 0u, 0u, 0u};
    if constexpr (STRIP) {
        xS = E.strip_pre(cur, wr, wc, fr, fq);
        sA = (const char*)g.A + ((size_t)MP + (size_t)(cur.pm >> 1) * 16) * K * 2;
        PG8_SSTG(0, sA); }
    size_t hsw = (STRIP && (cur.pm & 1)) ? hstep : 0;
    if constexpr (SP2) {
        PG8_STAGE(PG8_SB(0, 0), cB + hsw, voffB); PG8_STAGE(PG8_SB(0, 1), cB + (hstep - hsw), voffB); PG8_STAGE(PG8_SA(0, 0), cA, voffA); PG8_STAGE(PG8_SA(0, 1), cA + hstep, voffA);
        S.rs_all(tid);
        if (wr == 1) PG8_BAR;
        PG8_WAIT_V(2); PG8_BAR;
        PG8_STAGE(PG8_SB(1, 0), cB + hsw + kstep, voffB); PG8_STAGE(PG8_SA(1, 0), cA + kstep, voffA); PG8_STAGE(PG8_SB(1, 1), cB + (hstep - hsw) + kstep, voffB);
        PG8_WAIT_V(6); PG8_BAR;
    } else {
        S.a_ready(cur, 0, tid);
        PG8_STAGE(PG8_SB(0, 0), cB, voffB); PG8_STAGE(PG8_SA(0, 0), cA, voffA); PG8_STAGE(PG8_SB(0, 1), cB + hstep, voffB); PG8_STAGE(PG8_SA(0, 1), cA + hstep, voffA);
        if (wr == 1) PG8_BAR;
        PG8_WAIT_V(4); PG8_BAR;
        PG8_STAGE(PG8_SB(1, 0), cB + kstep, voffB); PG8_STAGE(PG8_SA(1, 0), cA + kstep, voffA); PG8_STAGE(PG8_SB(1, 1), cB + hstep + kstep, voffB);
        PG8_WAIT_V(6); PG8_BAR;
    }
    for (;;) {
        const bool has_next = S.next(ui + 1, nxt);
        const char* nA = has_next ? (const char*)g.A + (size_t)nxt.pm * tstep : cA; const char* nB = has_next ? (const char*)g.Bt + (size_t)nxt.pn * tstep : cB;
        const char* nsA = (STRIP && has_next) ? (const char*)g.A + ((size_t)MP + (size_t)(nxt.pm >> 1) * 16) * K * 2 : sA;
        const size_t nhsw = (STRIP && has_next) ? ((nxt.pm & 1) ? hstep : 0) : hsw;
        for (int t = 0; t < nt; t += 2) {
            const bool last = (t == nt - 2);
            const char* a1 = cA + (size_t)(t + 1) * kstep;
            const char* a2 = last ? nA : cA + (size_t)(t + 2) * kstep; const char* b2 = last ? nB : cB + (size_t)(t + 2) * kstep;
            const char* a3 = a2 + kstep; const char* b3 = b2 + kstep;
            if constexpr (SP2 && STRIP) {
            const char* s2 = last ? nsA : sA + (size_t)(t + 2) * kstep;
            const size_t hs2 = last ? nhsw : hsw; const char* b2l = b2 + hs2; const char* b2h = b2 + (hstep - hs2); const char* b3l = b2l + kstep; const char* b3h = b2h + kstep;
            PG8_LDB(B0, 0, 0); PG8_LDB(B1, 0, 1); PG8_SCHED; PG8_LDA(At, 0, 0); if (wr == 0) PG8_LDS(2 * sp, 0); PG8_STAGE(PG8_SA(1, 1), a1 + hstep, voffA);
            PG8_WAIT_V(8); PG8_WAIT_L(0); PG8_BAR; PG8_MMA(0, 0, At, B0); PG8_MMA(0, 1, At, B1); if (wr == 0) PG8_SMMA(0); PG8_BAR; PG8_SCHED;
            PG8_LDA(At, 0, 1); if (wr == 0) PG8_LDS(2 * sp, 1); PG8_SSTG(2 * (sp ^ 1), s2); PG8_STAGE(PG8_SB(0, 0), b2l, voffB); PG8_STAGE(PG8_SB(0, 1), b2h, voffB); PG8_STAGE(PG8_SA(0, 0), a2, voffA);
            PG8_WAIT_V(9); PG8_WAIT_L(0); PG8_BAR; PG8_MMA(1, 0, At, B0); PG8_MMA(1, 1, At, B1); if (wr == 0) PG8_SMMA(1); PG8_BAR; PG8_SCHED;
            PG8_LDB(B0, 1, 0); PG8_LDB(B1, 1, 1); PG8_SCHED; PG8_LDA(At, 1, 0); if (wr == 0) PG8_LDS(2 * sp + 1, 0); PG8_STAGE(PG8_SA(0, 1), a2 + hstep, voffA);
            PG8_WAIT_V(9); PG8_WAIT_L(0); PG8_BAR; PG8_MMA(0, 0, At, B0); PG8_MMA(0, 1, At, B1); if (wr == 0) PG8_SMMA(0); PG8_BAR; PG8_SCHED;
            PG8_LDA(At, 1, 1); if (wr == 0) PG8_LDS(2 * sp + 1, 1); PG8_STAGE(PG8_SB(1, 0), b3l, voffB); PG8_STAGE(PG8_SB(1, 1), b3h, voffB); PG8_STAGE(PG8_SA(1, 0), a3, voffA);
            PG8_WAIT_V(8); PG8_WAIT_L(0); PG8_BAR; PG8_MMA(1, 0, At, B0); PG8_MMA(1, 1, At, B1); if (wr == 0) PG8_SMMA(1); PG8_BAR; PG8_SCHED;
            sp ^= 1;
            } else if constexpr (SP2) {
            PG8_LDB(B0, 0, 0); PG8_LDB(B1, 0, 1); PG8_SCHED; PG8_LDA(At, 0, 0); PG8_STAGE(PG8_SA(1, 1), a1 + hstep, voffA);
            PG8_WAIT_V(8); PG8_WAIT_L(0); PG8_BAR; PG8_MMA(0, 0, At, B0); PG8_MMA(0, 1, At, B1); PG8_BAR; PG8_SCHED;
            PG8_LDA(At, 0, 1); PG8_STAGE(PG8_SB(0, 0), b2, voffB); PG8_STAGE(PG8_SB(0, 1), b2 + hstep, voffB); PG8_STAGE(PG8_SA(0, 0), a2, voffA);
            PG8_WAIT_V(8); PG8_WAIT_L(0); PG8_BAR; PG8_MMA(1, 0, At, B0); PG8_MMA(1, 1, At, B1); PG8_BAR; PG8_SCHED;
            PG8_LDB(B0, 1, 0); PG8_LDB(B1, 1, 1); PG8_SCHED; PG8_LDA(At, 1, 0); PG8_STAGE(PG8_SA(0, 1), a2 + hstep, voffA);
            PG8_WAIT_V(8); PG8_WAIT_L(0); PG8_BAR; PG8_MMA(0, 0, At, B0); PG8_MMA(0, 1, At, B1); PG8_BAR; PG8_SCHED;
            PG8_LDA(At, 1, 1); PG8_STAGE(PG8_SB(1, 0), b3, voffB); PG8_STAGE(PG8_SB(1, 1), b3 + hstep, voffB); PG8_STAGE(PG8_SA(1, 0), a3, voffA);
            PG8_WAIT_V(8); PG8_WAIT_L(0); PG8_BAR; PG8_MMA(1, 0, At, B0); PG8_MMA(1, 1, At, B1); PG8_BAR; PG8_SCHED;
            } else {
            PG8_LDB(B0, 0, 0); PG8_SCHED; PG8_LDA(At, 0, 0); PG8_STAGE(PG8_SA(1, 1), a1 + hstep, voffA);
            PG8_WAIT_L(8); PG8_BAR; PG8_WAIT_L(0); PG8_MMA(0, 0, At, B0); PG8_BAR; PG8_SCHED;
            PG8_LDB(B1, 0, 1); PG8_STAGE(PG8_SB(0, 0), b2, voffB);
            PG8_BAR; PG8_WAIT_L(0); PG8_MMA(0, 1, At, B1); PG8_BAR;
            PG8_LDA(At, 0, 1); PG8_STAGE(PG8_SA(0, 0), a2, voffA);
            PG8_BAR; PG8_WAIT_L(0); PG8_MMA(1, 0, At, B0); PG8_BAR; PG8_SCHED;
            PG8_STAGE(PG8_SB(0, 1), b2 + hstep, voffB);
            PG8_WAIT_V(6); PG8_BAR; PG8_MMA(1, 1, At, B1); PG8_BAR;
            PG8_LDB(B0, 1, 0); PG8_SCHED; PG8_LDA(At, 1, 0); PG8_STAGE(PG8_SA(0, 1), a2 + hstep, voffA);
            PG8_WAIT_L(8); PG8_BAR; PG8_WAIT_L(0); PG8_MMA(0, 0, At, B0); PG8_BAR; PG8_SCHED;
            PG8_LDB(B1, 1, 1); PG8_STAGE(PG8_SB(1, 0), b3, voffB);
            PG8_BAR; PG8_WAIT_L(0); PG8_MMA(0, 1, At, B1); PG8_BAR;
            PG8_LDA(At, 1, 1); PG8_STAGE(PG8_SA(1, 0), a3, voffA);
            PG8_BAR; PG8_WAIT_L(0); PG8_MMA(1, 0, At, B0); PG8_BAR; PG8_SCHED;
            PG8_STAGE(PG8_SB(1, 1), b3 + hstep, voffB);
            PG8_WAIT_V(6); PG8_BAR; PG8_MMA(1, 1, At, B1); PG8_BAR;
            }
        }
        if constexpr (ALIGN_EPI) { if (wr == 0) PG8_BAR; }
        if constexpr (STRIP && Epi::MERGED) { E.both(acc, accS, xS, cur, (LAS float*)(lds + RS_OFF + 5120), (LAS float*)(S.rs + ui * 256), wr, wc, fr, fq); break; }
        else if constexpr (STRIP && Epi::PRELOAD) {
            u32x4 xr[2][4][2]; E.preload(xr, cur, wr, wc, fr, fq);
            if constexpr (STRIP) { E.strip(accS, xS, cur, (LAS float*)(lds + RS_OFF + 5120), (const LAS float*)(S.rs + 1024 + ui * 16), wr, wc, fr, fq); accS[0] = accS[1] = (f32x4){0.f, 0.f, 0.f, 0.f}; sA = nsA; if (has_next) xS = E.strip_pre(nxt, wr, wc, fr, fq); }
            E.run2(acc, xr, cur, wr, wc, fr, fq, !has_next);
        }
        else {
        if constexpr (STRIP) { E.strip(accS, xS, cur, (LAS float*)(lds + RS_OFF + 5120), (const LAS float*)(S.rs + 1024 + ui * 16), wr, wc, fr, fq); accS[0] = accS[1] = (f32x4){0.f, 0.f, 0.f, 0.f}; sA = nsA; if (has_next) xS = E.strip_pre(nxt, wr, wc, fr, fq); }
        E(acc, cur, (const LAS float*)(S.rs + ui * 256), wr, wc, fr, fq, !has_next);
        }
        if (!has_next) break;
#pragma unroll
        for (int a = 0; a < 2; ++a)
#pragma unroll
            for (int b = 0; b < 2; ++b)
#pragma unroll
                for (int m = 0; m < 4; ++m)
#pragma unroll
                    for (int n = 0; n < 2; ++n) acc[a][b][m][n] = (f32x4){0.f, 0.f, 0.f, 0.f};
        cur = nxt; cA = nA; cB = nB; hsw = nhsw; ++ui;
        if constexpr (ALIGN_EPI) { if (wr == 1) PG8_BAR; }
    }
    PG8_WAIT_V(0);
    if constexpr (!ALIGN_EPI) { if (wr == 0) PG8_BAR; }
    PG8_BAR;
#undef PG8_SA
#undef PG8_SB
#undef PG8_STAGE
#undef PG8_SSTG
#undef PG8_LDS
#undef PG8_SMMA
#undef PG8_LDA
#undef PG8_LDB
#undef PG8_MMA
#undef PG8_WAIT_V
#undef PG8_WAIT_L
#undef PG8_BAR
#undef PG8_SCHED
}
}
using pg8::Unit;

struct EpiSwiGLU {
    static constexpr bool PRELOAD = false;
    static constexpr bool MERGED = false;
    bf16_t* O;
    DI void operator()(f32x4 (&acc)[2][2][4][2], const Unit& u, const LAS float* rs, int wr, int wc, int fr, int fq, bool wt = false) const {
        const int col0 = u.pn * 128 + wc * 32 + 8 * fq; const rsrc_t ro = mk_rsrc(O);
#pragma unroll
        for (int ai = 0; ai < 2; ++ai)
#pragma unroll
            for (int m = 0; m < 4; ++m) {
                const int rl = ai * 128 + wr * 64 + m * 16 + fr; const float r = rs[rl], rn = -r * LOG2E, rr = r * r;
                f32x2 o[4];
#pragma unroll
                for (int n = 0; n < 2; ++n)
#pragma unroll
                    for (int h = 0; h < 2; ++h) {
                        const f32x2 g = {acc[ai][0][m][n][2 * h], acc[ai][0][m][n][2 * h + 1]}, uu = {acc[ai][1][m][n][2 * h], acc[ai][1][m][n][2 * h + 1]};
                        const f32x2 w = g * rn;
                        const f32x2 d = (f32x2){__builtin_amdgcn_exp2f(w.x), __builtin_amdgcn_exp2f(w.y)} + 1.0f;
                        const f32x2 sg = (f32x2){__builtin_amdgcn_rcpf(d.x), __builtin_amdgcn_rcpf(d.y)} * rr;
                        o[n * 2 + h] = (g * uu) * sg; }
                u32x4 w; w.x = pk2(o[0].x, o[0].y); w.y = pk2(o[1].x, o[1].y); w.z = pk2(o[2].x, o[2].y); w.w = pk2(o[3].x, o[3].y);
                bst16w(ro, __umul24(u.pm * 256 + rl, FF * 2) + col0 * 2, w, wt);
            }
    }
};
struct EpiResid {
    static constexpr bool PRELOAD = true;
    static constexpr bool MERGED = false;
    const float* in_lo; const float* in_hi;
    bf16_t* XB; float* ssp; float s;
    DI void operator()(f32x4 (&acc)[2][2][4][2], const Unit& u, const LAS float* rs, int wr, int wc, int fr, int fq, bool wt = false) const { run(acc, u, wr, wc, fr, fq, wt); }
    DI void preload(u32x4 (&xr)[2][4][2], const Unit& u, int wr, int wc, int fr, int fq) const {
        asm volatile("" : "+v"(fr), "+v"(fq));
        const rsrc_t rx = mk_rsrc(XB); const int sw = u.pm & 1;
#pragma unroll
        for (int ai = 0; ai < 2; ++ai)
#pragma unroll
            for (int m = 0; m < 4; ++m)
#pragma unroll
                for (int bj = 0; bj < 2; ++bj)
                    xr[ai][m][bj] = bld16(rx, (unsigned)(u.pm * 256 + ai * 128 + wr * 64 + m * 16 + fr) * (DM * 2) + (u.pn * 256 + (bj ^ sw) * 128 + wc * 32 + 8 * fq) * 2);
    }
    DI void run(const f32x4 (&acc)[2][2][4][2], const Unit& u, int wr, int wc, int fr, int fq, bool wt = false) const {
        u32x4 xr[2][4][2];
        preload(xr, u, wr, wc, fr, fq);
        run2(acc, xr, u, wr, wc, fr, fq, wt); }
    DI void run2(const f32x4 (&acc)[2][2][4][2], const u32x4 (&xr)[2][4][2], const Unit& u, int wr, int wc, int fr, int fq, bool wt) const {
        const rsrc_t rx = mk_rsrc(XB);
        const int sw = u.pm & 1;
        asm volatile("" ::: "memory");
#pragma unroll
        for (int ai = 0; ai < 2; ++ai) {
#pragma unroll
            for (int m = 0; m < 4; ++m) {
                const int row = u.pm * 256 + ai * 128 + wr * 64 + m * 16 + fr; f32x2 q2 = {0.f, 0.f};
#pragma unroll
                for (int bj = 0; bj < 2; ++bj) {
                    const size_t off = (size_t)row * DM + u.pn * 256 + (bj ^ sw) * 128 + wc * 32 + 8 * fq; const u32x4 x = xr[ai][m][bj];
                    const f32x4 a = (f32x4){bflo(x.x), bfhi(x.x), bflo(x.y), bfhi(x.y)} + acc[ai][bj][m][0] * s, b = (f32x4){bflo(x.z), bfhi(x.z), bflo(x.w), bfhi(x.w)} + acc[ai][bj][m][1] * s;
                    u32x4 w; w.x = pk2(a[0], a[1]); w.y = pk2(a[2], a[3]); w.z = pk2(b[0], b[1]); w.w = pk2(b[2], b[3]);
                    bst16w(rx, (unsigned)off * 2u, w, wt);
                    const f32x2 a0 = {a[0], a[1]}, a1 = {a[2], a[3]}, b0 = {b[0], b[1]}, b1 = {b[2], b[3]};
                    q2 = q2 + a0 * a0; q2 = q2 + a1 * a1; q2 = q2 + b0 * b0; q2 = q2 + b1 * b1;
                }
                float q = q2.x + q2.y; q += shx<16>(q); q = add32(q);
                if (fq == 0) ssp[(size_t)(u.pn * 4 + wc) * MROWS + row] = q;
            }
        }
        asm volatile("" ::: "memory");
    }
    DI u32x4 strip_pre(const Unit& u, int wr, int wc, int fr, int fq) const {
        u32x4 x = {0u, 0u, 0u, 0u};
        if (wr == 0) x = *(const u32x4*)(XB + (size_t)(MP + (u.pm >> 1) * 16 + fr) * DM + u.pn * 256 + (u.pm & 1) * 128 + wc * 32 + 8 * fq);
        return x; }
    DI void strip(const f32x4 (&accS)[2], const u32x4 x, const Unit& u, LAS float* ls, const LAS float*, int wr, int wc, int fr, int fq) const {
        asm volatile("" : "+v"(fr), "+v"(fq));
        const int row = MP + (u.pm >> 1) * 16 + fr, bj = u.pm & 1;
        if (wr == 0) {
            const size_t off = (size_t)row * DM + u.pn * 256 + bj * 128 + wc * 32 + 8 * fq;
            const f32x4 a = (f32x4){bflo(x.x), bfhi(x.x), bflo(x.y), bfhi(x.y)} + accS[0] * s, b = (f32x4){bflo(x.z), bfhi(x.z), bflo(x.w), bfhi(x.w)} + accS[1] * s;
            u32x4 w; w.x = pk2(a[0], a[1]); w.y = pk2(a[2], a[3]); w.z = pk2(b[0], b[1]); w.w = pk2(b[2], b[3]);
            *(u32x4*)(XB + off) = w;
            float q = (a[0] * a[0] + a[1] * a[1]) + (a[2] * a[2] + a[3] * a[3]) + (b[0] * b[0] + b[1] * b[1]) + (b[2] * b[2] + b[3] * b[3]);
            q += shx<16>(q); q = add32(q);
            if (fq == 0) ls[fr * 4 + wc] = q;
        }
        asm volatile("s_waitcnt lgkmcnt(0)" ::: "memory"); __builtin_amdgcn_s_barrier(); asm volatile("" ::: "memory");
        if (wr == 0 && wc == 0 && fq < 2) {
            const float p = ls[fr * 4 + 2 * fq] + ls[fr * 4 + 2 * fq + 1];
            ssp[(size_t)(u.pn * 4 + bj * 2 + fq) * MROWS + row] = p; }
    }
};
struct EpiFinal {
    static constexpr bool PRELOAD = false;
    bf16_t* XB; float s; float* Y; const float* gain; float* xs; unsigned* cnt;
    static constexpr bool MERGED = true;
    DI void both(f32x4 (&acc)[2][2][4][2], const f32x4 (&accS)[2], const u32x4 x, const Unit& u, LAS float* lsS, LAS float* ls, int wr, int wc, int fr, int fq) const {
        asm volatile("" : "+v"(fr), "+v"(fq));
        const int tid = (wr * 4 + wc) * 64 + fq * 16 + fr, rb = u.pm >> 1, bjS = u.pm & 1, rowS = MP + rb * 16 + fr, colS = u.pn * 256 + bjS * 128 + wc * 32 + 8 * fq;
        float* xs2 = xs + (size_t)MP * 4; unsigned* cS = cnt + 64 * (64 + rb); unsigned* cT = cnt + 64 * u.pm;
        f32x4 a = {0.f, 0.f, 0.f, 0.f}, b = a;
        if (wr == 0) {
            a = (f32x4){bflo(x.x), bfhi(x.x), bflo(x.y), bfhi(x.y)} + accS[0] * s; b = (f32x4){bflo(x.z), bfhi(x.z), bflo(x.w), bfhi(x.w)} + accS[1] * s;
            float q = (a[0] * a[0] + a[1] * a[1]) + (a[2] * a[2] + a[3] * a[3]) + (b[0] * b[0] + b[1] * b[1]) + (b[2] * b[2] + b[3] * b[3]);
            q += shx<16>(q); q = add32(q);
            if (fq == 0) lsS[fr * 4 + wc] = q;
        }
        u32x4 xr[2][4][2];
#pragma unroll
        for (int ai = 0; ai < 2; ++ai)
#pragma unroll
            for (int m = 0; m < 4; ++m)
#pragma unroll
                for (int bj = 0; bj < 2; ++bj) xr[ai][m][bj] = *(const u32x4*)(XB + (size_t)(u.pm * 256 + ai * 128 + wr * 64 + m * 16 + fr) * DM + u.pn * 256 + (bj ^ (u.pm & 1)) * 128 + wc * 32 + 8 * fq);
        asm volatile("" ::: "memory");
#pragma unroll
        for (int ai = 0; ai < 2; ++ai) {
#pragma unroll
            for (int m = 0; m < 4; ++m) { float q = 0.f;
#pragma unroll
                for (int bj = 0; bj < 2; ++bj) { const u32x4 xx = xr[ai][m][bj];
                    const f32x4 ta = (f32x4){bflo(xx.x), bfhi(xx.x), bflo(xx.y), bfhi(xx.y)} + acc[ai][bj][m][0] * s, tb = (f32x4){bflo(xx.z), bfhi(xx.z), bflo(xx.w), bfhi(xx.w)} + acc[ai][bj][m][1] * s;
                    acc[ai][bj][m][0] = ta; acc[ai][bj][m][1] = tb;
                    q += (ta[0] * ta[0] + ta[1] * ta[1]) + (ta[2] * ta[2] + ta[3] * ta[3]) + (tb[0] * tb[0] + tb[1] * tb[1]) + (tb[2] * tb[2] + tb[3] * tb[3]); }
                q += shx<16>(q); q = add32(q);
                if (fq == 0) ls[(ai * 128 + wr * 64 + m * 16 + fr) * 4 + wc] = q; }
        }
        asm volatile("s_waitcnt lgkmcnt(0)" ::: "memory"); __builtin_amdgcn_s_barrier(); asm volatile("" ::: "memory");
        if (tid < 256) { const float p = (ls[tid * 4] + ls[tid * 4 + 1]) + (ls[tid * 4 + 2] + ls[tid * 4 + 3]); st4_wt(xs + (size_t)(u.pm * 256 + tid) * 4 + u.pn, p); }
        if (wr == 0 && wc == 0 && fq < 2) st4_wt(xs2 + (size_t)(rowS - MP) * 16 + u.pn * 4 + bjS * 2 + fq, lsS[fr * 4 + 2 * fq] + lsS[fr * 4 + 2 * fq + 1]);
        asm volatile("s_waitcnt vmcnt(0) lgkmcnt(0)" ::: "memory"); __builtin_amdgcn_s_barrier(); asm volatile("" ::: "memory");
        if (tid == 0) { __hip_atomic_fetch_add(cT, 1u, __ATOMIC_RELAXED, __HIP_MEMORY_SCOPE_AGENT); __hip_atomic_fetch_add(cS, 1u, __ATOMIC_RELAXED, __HIP_MEMORY_SCOPE_AGENT);
            for (unsigned sp = 0; __hip_atomic_load(cT, __ATOMIC_RELAXED, __HIP_MEMORY_SCOPE_AGENT) < 4u && sp < (1u << 18); ++sp) __builtin_amdgcn_s_sleep(2);
            for (unsigned sp = 0; __hip_atomic_load(cS, __ATOMIC_RELAXED, __HIP_MEMORY_SCOPE_AGENT) < 8u && sp < (1u << 18); ++sp) __builtin_amdgcn_s_sleep(2);
            __builtin_amdgcn_fence(__ATOMIC_ACQUIRE, "agent"); asm volatile("s_waitcnt vmcnt(0)" ::: "memory"); }
        asm volatile("" ::: "memory"); __builtin_amdgcn_s_barrier(); asm volatile("" ::: "memory");
        f32x4 gn[2][2], gS[2];
#pragma unroll
        for (int bj = 0; bj < 2; ++bj) { const int col = u.pn * 256 + (bj ^ (u.pm & 1)) * 128 + wc * 32 + 8 * fq; gn[bj][0] = *(const f32x4*)(gain + col); gn[bj][1] = *(const f32x4*)(gain + col + 4); }
        gS[0] = *(const f32x4*)(gain + colS); gS[1] = *(const f32x4*)(gain + colS + 4);
        float rS = 0.f;
        if (tid < 256) { const f32x4 p4 = *(const f32x4*)(xs + (size_t)(u.pm * 256 + tid) * 4);
            const float* sl = xs2 + (size_t)(rowS - MP) * 16;
            const f32x4 p0 = *(const f32x4*)(sl), p1 = *(const f32x4*)(sl + 4), p2 = *(const f32x4*)(sl + 8), p3 = *(const f32x4*)(sl + 12);
            ls[1024 + tid] = rsqrtf(((p4[0] + p4[1]) + (p4[2] + p4[3])) * (1.0f / DM) + EPS);
            const float tot = ((p0[0] + p0[1]) + (p0[2] + p0[3])) + ((p1[0] + p1[1]) + (p1[2] + p1[3])) + ((p2[0] + p2[1]) + (p2[2] + p2[3])) + ((p3[0] + p3[1]) + (p3[2] + p3[3]));
            rS = rsqrtf(tot * (1.0f / DM) + EPS); }
        asm volatile("s_waitcnt vmcnt(0) lgkmcnt(0)" ::: "memory"); __builtin_amdgcn_s_barrier(); asm volatile("" ::: "memory");
#pragma unroll
        for (int ai = 0; ai < 2; ++ai)
#pragma unroll
            for (int m = 0; m < 4; ++m) { const int rl = ai * 128 + wr * 64 + m * 16 + fr; const float r = ls[1024 + rl];
#pragma unroll
                for (int bj = 0; bj < 2; ++bj) { const int col = u.pn * 256 + (bj ^ (u.pm & 1)) * 128 + wc * 32 + 8 * fq; const size_t off = (size_t)(u.pm * 256 + rl) * DM + col;
                    *(f32x4*)(Y + off) = acc[ai][bj][m][0] * r * gn[bj][0]; *(f32x4*)(Y + off + 4) = acc[ai][bj][m][1] * r * gn[bj][1]; } }
        if (wr == 0) { *(f32x4*)(Y + (size_t)rowS * DM + colS) = a * rS * gS[0]; *(f32x4*)(Y + (size_t)rowS * DM + colS + 4) = b * rS * gS[1]; }
    }
    DI void operator()(f32x4 (&acc)[2][2][4][2], const Unit& u, const LAS float* rs, int wr, int wc, int fr, int fq, bool = false) const { run_final(acc, u, (LAS float*)rs, wr, wc, fr, fq); }
    DI void run_final(f32x4 (&acc)[2][2][4][2], const Unit& u, LAS float* ls, int wr, int wc, int fr, int fq) const {
        const int tid = (wr * 4 + wc) * 64 + fq * 16 + fr;
#pragma unroll
        for (int ai = 0; ai < 2; ++ai) {
#pragma unroll
            for (int m = 0; m < 4; ++m) { float q = 0.f; u32x4 xin[2];
#pragma unroll
                for (int bj = 0; bj < 2; ++bj) xin[bj] = *(const u32x4*)(XB + (size_t)(u.pm * 256 + ai * 128 + wr * 64 + m * 16 + fr) * DM + u.pn * 256 + (bj ^ (u.pm & 1)) * 128 + wc * 32 + 8 * fq);
#pragma unroll
                for (int bj = 0; bj < 2; ++bj) { const u32x4 x = xin[bj];
                    const f32x4 a = (f32x4){bflo(x.x), bfhi(x.x), bflo(x.y), bfhi(x.y)} + acc[ai][bj][m][0] * s, b = (f32x4){bflo(x.z), bfhi(x.z), bflo(x.w), bfhi(x.w)} + acc[ai][bj][m][1] * s;
                    acc[ai][bj][m][0] = a; acc[ai][bj][m][1] = b;
                    q += (a[0] * a[0] + a[1] * a[1]) + (a[2] * a[2] + a[3] * a[3]) + (b[0] * b[0] + b[1] * b[1]) + (b[2] * b[2] + b[3] * b[3]); }
                q += shx<16>(q); q = add32(q);
                if (fq == 0) ls[(ai * 128 + wr * 64 + m * 16 + fr) * 4 + wc] = q; }
        }
        asm volatile("s_waitcnt lgkmcnt(0)" ::: "memory"); __builtin_amdgcn_s_barrier(); asm volatile("" ::: "memory");
        if (tid < 256) { const float p = (ls[tid * 4] + ls[tid * 4 + 1]) + (ls[tid * 4 + 2] + ls[tid * 4 + 3]); st4_wt(xs + (size_t)(u.pm * 256 + tid) * 4 + u.pn, p); }
        asm volatile("s_waitcnt vmcnt(0) lgkmcnt(0)" ::: "memory"); __builtin_amdgcn_s_barrier(); asm volatile("" ::: "memory");
        if (tid == 0) { __hip_atomic_fetch_add(cnt + 64 * u.pm, 1u, __ATOMIC_RELAXED, __HIP_MEMORY_SCOPE_AGENT); wait_count(cnt + 64 * u.pm, 4u); }
        asm volatile("" ::: "memory"); __builtin_amdgcn_s_barrier(); asm volatile("" ::: "memory");
        f32x4 gn[2][2];
#pragma unroll
        for (int bj = 0; bj < 2; ++bj) { const int col = u.pn * 256 + (bj ^ (u.pm & 1)) * 128 + wc * 32 + 8 * fq; gn[bj][0] = *(const f32x4*)(gain + col); gn[bj][1] = *(const f32x4*)(gain + col + 4); }
        if (tid < 256) { const f32x4 p4 = *(const f32x4*)(xs + (size_t)(u.pm * 256 + tid) * 4); ls[1024 + tid] = rsqrtf(((p4[0] + p4[1]) + (p4[2] + p4[3])) * (1.0f / DM) + EPS); }
        asm volatile("s_waitcnt vmcnt(0) lgkmcnt(0)" ::: "memory"); __builtin_amdgcn_s_barrier(); asm volatile("" ::: "memory");
#pragma unroll
        for (int ai = 0; ai < 2; ++ai)
#pragma unroll
            for (int m = 0; m < 4; ++m) { const int rl = ai * 128 + wr * 64 + m * 16 + fr; const float r = ls[1024 + rl];
#pragma unroll
                for (int bj = 0; bj < 2; ++bj) { const int col = u.pn * 256 + (bj ^ (u.pm & 1)) * 128 + wc * 32 + 8 * fq; const size_t off = (size_t)(u.pm * 256 + rl) * DM + col;
                    *(f32x4*)(Y + off) = acc[ai][bj][m][0] * r * gn[bj][0]; *(f32x4*)(Y + off + 4) = acc[ai][bj][m][1] * r * gn[bj][1]; } }
    }
    DI u32x4 strip_pre(const Unit& u, int wr, int wc, int fr, int fq) const {
        u32x4 x = {0u, 0u, 0u, 0u};
        if (wr == 0) x = *(const u32x4*)(XB + (size_t)(MP + (u.pm >> 1) * 16 + fr) * DM + u.pn * 256 + (u.pm & 1) * 128 + wc * 32 + 8 * fq);
        return x; }
    DI void strip(const f32x4 (&accS)[2], const u32x4 x, const Unit& u, LAS float* ls, const LAS float*, int wr, int wc, int fr, int fq) const {
        asm volatile("" : "+v"(fr), "+v"(fq));
        const int tid = (wr * 4 + wc) * 64 + fq * 16 + fr, rb = u.pm >> 1, bj = u.pm & 1, row = MP + rb * 16 + fr, col = u.pn * 256 + bj * 128 + wc * 32 + 8 * fq;
        float* xs2 = xs + (size_t)MP * 4; unsigned* c = cnt + 64 * (64 + rb);
        f32x4 a = {0.f, 0.f, 0.f, 0.f}, b = a;
        if (wr == 0) {
            a = (f32x4){bflo(x.x), bfhi(x.x), bflo(x.y), bfhi(x.y)} + accS[0] * s; b = (f32x4){bflo(x.z), bfhi(x.z), bflo(x.w), bfhi(x.w)} + accS[1] * s;
            float q = (a[0] * a[0] + a[1] * a[1]) + (a[2] * a[2] + a[3] * a[3]) + (b[0] * b[0] + b[1] * b[1]) + (b[2] * b[2] + b[3] * b[3]);
            q += shx<16>(q); q = add32(q);
            if (fq == 0) ls[fr * 4 + wc] = q;
        }
        asm volatile("s_waitcnt lgkmcnt(0)" ::: "memory"); __builtin_amdgcn_s_barrier(); asm volatile("" ::: "memory");
        if (wr == 0 && wc == 0 && fq < 2) st4_wt(xs2 + (size_t)(row - MP) * 16 + u.pn * 4 + bj * 2 + fq, ls[fr * 4 + 2 * fq] + ls[fr * 4 + 2 * fq + 1]);
        asm volatile("s_waitcnt vmcnt(0) lgkmcnt(0)" ::: "memory"); __builtin_amdgcn_s_barrier(); asm volatile("" ::: "memory");
        if (tid == 0) { __hip_atomic_fetch_add(c, 1u, __ATOMIC_RELAXED, __HIP_MEMORY_SCOPE_AGENT); wait_count(c, 8u); }
        asm volatile("" ::: "memory"); __builtin_amdgcn_s_barrier(); asm volatile("" ::: "memory");
        if (wr == 0) {
            const float* sl = xs2 + (size_t)(row - MP) * 16;
            const f32x4 p0 = *(const f32x4*)(sl), p1 = *(const f32x4*)(sl + 4), p2 = *(const f32x4*)(sl + 8), p3 = *(const f32x4*)(sl + 12);
            const float tot = ((p0[0] + p0[1]) + (p0[2] + p0[3])) + ((p1[0] + p1[1]) + (p1[2] + p1[3])) + ((p2[0] + p2[1]) + (p2[2] + p2[3])) + ((p3[0] + p3[1]) + (p3[2] + p3[3]));
            const float r = rsqrtf(tot * (1.0f / DM) + EPS);
            *(f32x4*)(Y + (size_t)row * DM + col) = a * r * *(const f32x4*)(gain + col); *(f32x4*)(Y + (size_t)row * DM + col + 4) = b * r * *(const f32x4*)(gain + col + 4);
        }
    }
};
struct EpiProj0 {
    static constexpr bool PRELOAD = false;
    static constexpr bool MERGED = false;
    bf16_t *Q, *K, *V, *UP;
    DI void operator()(f32x4 (&acc)[2][2][4][2], const Unit& u, const LAS float* rs, int wr, int wc, int fr, int fq, bool wt = false) const {
#pragma unroll
        for (int bj = 0; bj < 2; ++bj) {
            bf16_t* base; int pitch, c0; float sc = 1.f;
            if (u.pn < 2) { base = Q; pitch = 512; c0 = u.pn * 256 + bj * 128; sc = 0.125f; }
            else if (u.pn == 2) { base = bj ? V : K; pitch = 128; c0 = 0; }
            else { base = UP; pitch = 512; c0 = (u.pn - 3) * 256 + bj * 128; }
            c0 += wc * 32 + 8 * fq;
#pragma unroll
            for (int ai = 0; ai < 2; ++ai)
#pragma unroll
                for (int m = 0; m < 4; ++m) {
                    const int rl = ai * 128 + wr * 64 + m * 16 + fr; const float r = rs[rl] * sc;
                    const f32x4 a = acc[ai][bj][m][0] * r, b = acc[ai][bj][m][1] * r;
                    u32x4 w; w.x = pk2(a[0], a[1]); w.y = pk2(a[2], a[3]); w.z = pk2(b[0], b[1]); w.w = pk2(b[2], b[3]);
                    bst16w(mk_rsrc(base), (unsigned)(u.pm * 256 + rl) * (unsigned)(pitch * 2) + (unsigned)(c0 * 2), w, wt);
                }
        }
    }
};
constexpr float GELU_A = -1.5957691216057308f * LOG2E, GELU_B = GELU_A * 0.044715f;
DI float gelu_tanh(float x) { const float u2 = 1.5957691216057308f * (x + 0.044715f * x * x * x); return x * __builtin_amdgcn_rcpf(1.0f + __builtin_amdgcn_exp2f(-u2 * LOG2E)); }
struct EpiGeluUV {
    static constexpr bool PRELOAD = false;
    static constexpr bool MERGED = false;
    bf16_t *U, *V1; float* ssp;
    DI void operator()(f32x4 (&acc)[2][2][4][2], const Unit& u, const LAS float* rs, int wr, int wc, int fr, int fq, bool wt = false) const {
        const bool isv = u.pn >= 4; bf16_t* base = isv ? V1 : U; const int pc = (isv ? u.pn - 4 : u.pn) * 256;
#pragma unroll
        for (int ai = 0; ai < 2; ++ai)
#pragma unroll
            for (int m = 0; m < 4; ++m) {
                const int rl = ai * 128 + wr * 64 + m * 16 + fr, row = u.pm * 256 + rl; const float r = rs[rl]; f32x2 q2 = {0.f, 0.f};
#pragma unroll
                for (int bj = 0; bj < 2; ++bj) {
                    f32x2 o[4], xx[4], ww[4], dd[4];
#pragma unroll
                    for (int p = 0; p < 4; ++p) { xx[p] = (f32x2){acc[ai][bj][m][p >> 1][2 * (p & 1)], acc[ai][bj][m][p >> 1][2 * (p & 1) + 1]} * r; ww[p] = xx[p] * ((xx[p] * xx[p]) * GELU_B + GELU_A); }
#pragma unroll
                    for (int p = 0; p < 4; ++p) dd[p] = (f32x2){__builtin_amdgcn_exp2f(ww[p].x), __builtin_amdgcn_exp2f(ww[p].y)};
#pragma unroll
                    for (int p = 0; p < 4; ++p) dd[p] = dd[p] + 1.0f;
#pragma unroll
                    for (int p = 0; p < 4; ++p) dd[p] = (f32x2){__builtin_amdgcn_rcpf(dd[p].x), __builtin_amdgcn_rcpf(dd[p].y)};
#pragma unroll
                    for (int p = 0; p < 4; ++p) { o[p] = xx[p] * dd[p]; q2 = q2 + o[p] * o[p]; }
                    u32x4 w; w.x = pk2(o[0].x, o[0].y); w.y = pk2(o[1].x, o[1].y); w.z = pk2(o[2].x, o[2].y); w.w = pk2(o[3].x, o[3].y);
                    bst16w(mk_rsrc(base), (unsigned)row * (DM * 2) + (unsigned)((pc + (bj ^ (u.pm & 1)) * 128 + wc * 32 + 8 * fq) * 2), w, wt);
                }
                if (isv) { float q = q2.x + q2.y; q += shx<16>(q); q = add32(q); if (fq == 0) ssp[(size_t)((u.pn - 4) * 4 + wc) * MROWS + row] = q; }
            }
    }
    DI u32x4 strip_pre(const Unit&, int, int, int, int) const { return (u32x4){0u, 0u, 0u, 0u}; }
    DI void strip(const f32x4 (&accS)[2], const u32x4, const Unit& u, LAS float* ls, const LAS float* rsS, int wr, int wc, int fr, int fq) const {
        asm volatile("" : "+v"(fr), "+v"(fq));
        const int row = MP + (u.pm >> 1) * 16 + fr, bj = u.pm & 1; const bool isv = u.pn >= 4; bf16_t* base = isv ? V1 : U; const int pc = (isv ? u.pn - 4 : u.pn) * 256;
        if (wr == 0) {
            const float r = rsS[fr]; f32x2 o[4], xx[4], ww[4], dd[4], q2 = {0.f, 0.f};
#pragma unroll
            for (int p = 0; p < 4; ++p) { xx[p] = (f32x2){accS[p >> 1][2 * (p & 1)], accS[p >> 1][2 * (p & 1) + 1]} * r; ww[p] = xx[p] * ((xx[p] * xx[p]) * GELU_B + GELU_A); }
#pragma unroll
            for (int p = 0; p < 4; ++p) dd[p] = (f32x2){__builtin_amdgcn_exp2f(ww[p].x), __builtin_amdgcn_exp2f(ww[p].y)};
#pragma unroll
            for (int p = 0; p < 4; ++p) dd[p] = dd[p] + 1.0f;
#pragma unroll
            for (int p = 0; p < 4; ++p) dd[p] = (f32x2){__builtin_amdgcn_rcpf(dd[p].x), __builtin_amdgcn_rcpf(dd[p].y)};
#pragma unroll
            for (int p = 0; p < 4; ++p) { o[p] = xx[p] * dd[p]; q2 = q2 + o[p] * o[p]; }
            u32x4 w; w.x = pk2(o[0].x, o[0].y); w.y = pk2(o[1].x, o[1].y); w.z = pk2(o[2].x, o[2].y); w.w = pk2(o[3].x, o[3].y);
            *(u32x4*)(base + (size_t)row * DM + pc + bj * 128 + wc * 32 + 8 * fq) = w;
            float q = q2.x + q2.y; q += shx<16>(q); q = add32(q);
            if (fq == 0) ls[fr * 4 + wc] = q;
        }
        asm volatile("s_waitcnt lgkmcnt(0)" ::: "memory"); __builtin_amdgcn_s_barrier(); asm volatile("" ::: "memory");
        if (isv && wr == 0 && wc == 0 && fq < 2) ssp[(size_t)((u.pn - 4) * 4 + bj * 2 + fq) * MROWS + row] = ls[fr * 4 + 2 * fq] + ls[fr * 4 + 2 * fq + 1];
    }
};

#define XB_TMO      128
#define XB_XCNT(j)  (256  + 64 * (j))
#define XB_XSUB(j)  (1280 + 64 * (j))
#define XB_XGEN(j)  (2304 + 64 * (j))
#define XB_TOP      3328
#define XB_TOPGEN   3392
#define XCD_BAR_WORDS 3456
#define XB_SPIN_CAP (1u << 18)
DI unsigned xb_ld(unsigned* p)              { return __hip_atomic_load(p, __ATOMIC_RELAXED, __HIP_MEMORY_SCOPE_AGENT); }
DI unsigned xb_add(unsigned* p, unsigned v) { return __hip_atomic_fetch_add(p, v, __ATOMIC_RELAXED, __HIP_MEMORY_SCOPE_AGENT); }
DI unsigned xb_xcc_id() { return (unsigned)__builtin_amdgcn_s_getreg((3 << 11) | 20) & 0xFu; }
#define XB_SPIN(cond, bar) do { unsigned _sp = 0; while (cond) { __builtin_amdgcn_s_sleep(1); \
    if ((++_sp & 255u) == 0u) { if (xb_ld(&(bar)[XB_TMO])) break; if (_sp > XB_SPIN_CAP) { atomicAdd(&(bar)[XB_TMO], 1u); break; } } } } while (0)
struct XcdBarrier { unsigned* bar; unsigned x; volatile LAS unsigned* st; };
DI XcdBarrier xcd_barrier_post(unsigned* bar, volatile LAS unsigned* st) {
    XcdBarrier b; b.bar = bar; b.x = xb_xcc_id(); b.st = st;
    if (threadIdx.x == 0) (void)xb_add(&bar[XB_XCNT(b.x)], 1u);
    return b;
}
DI void xcd_barrier_complete(unsigned* bar, unsigned x, unsigned& nloc, unsigned& nx) {
    const unsigned G = GRID;
    unsigned sum, cnt, mine, sp = 0u;
    for (;;) {
        sum = 0u; cnt = 0u; mine = 0u;
#pragma unroll
        for (unsigned j = 0; j < 16; ++j) { const unsigned c = xb_ld(&bar[XB_XCNT(j)]); sum += c; cnt += (c > 0u) ? 1u : 0u; mine = (j == x) ? c : mine; }
        if (sum == G) break;
        __builtin_amdgcn_s_sleep(1);
        if ((++sp & 255u) == 0u) { if (xb_ld(&bar[XB_TMO])) break; if (sp > XB_SPIN_CAP) { atomicAdd(&bar[XB_TMO], 1u); break; } }
    }
    nloc = mine > 0u ? mine : 1u; nx = cnt > 0u ? cnt : 1u;
}
DI void xcd_barrier(const XcdBarrier& b) {
    asm volatile("s_waitcnt vmcnt(0)" ::: "memory");
    __syncthreads();
    if (threadIdx.x == 0) {
        unsigned* bar = b.bar;
        __builtin_amdgcn_s_waitcnt(0);
        unsigned nloc = b.st[0], nx = b.st[1];
        if (nloc == 0u) { xcd_barrier_complete(bar, b.x, nloc, nx); b.st[0] = nloc; b.st[1] = nx; }
        const unsigned old = xb_add(&bar[XB_XSUB(b.x)], 1u);
        const unsigned gen = old / nloc;
        if (old + 1u == (gen + 1u) * nloc) {
            asm volatile("buffer_inv sc1" ::: "memory");
            __builtin_amdgcn_fence(__ATOMIC_RELEASE, "agent");
            asm volatile("s_waitcnt vmcnt(0)" ::: "memory");
            const unsigned og = xb_add(&bar[XB_TOP], 1u);
            const unsigned tg = og / nx;
            if (og + 1u == (tg + 1u) * nx) xb_add(&bar[XB_TOPGEN], 1u);
            else XB_SPIN(xb_ld(&bar[XB_TOPGEN]) == tg, bar);
            xb_add(&bar[XB_XGEN(b.x)], 1u);
            asm volatile("s_waitcnt vmcnt(0)" ::: "memory");
        } else {
            asm volatile("buffer_inv sc1" ::: "memory");
            XB_SPIN(xb_ld(&bar[XB_XGEN(b.x)]) == gen, bar);
            asm volatile("s_waitcnt vmcnt(0)" ::: "memory");
        }
    }
    __syncthreads();
}

struct TrD { const float* W; const float* gain; bf16_t* WT; int K, N, mode, item; };
DI void tr_load(const TrD& d, int lane, f32x4 (&v)[8], float (&g)[8]) {
    const int nblk = d.N / 32, kb = d.item / nblk, nb = d.item % nblk, k0 = 64 * kb, n0 = 32 * nb, kr = lane >> 3, n4 = (lane & 7) * 4;
#pragma unroll
    for (int i = 0; i < 8; ++i) v[i] = __builtin_nontemporal_load((const f32x4*)(d.W + (size_t)(k0 + 8 * i + kr) * d.N + n0 + n4));
#pragma unroll
    for (int i = 0; i < 8; ++i) g[i] = d.gain ? d.gain[k0 + 8 * i + kr] : 1.0f;
}
DI void tr_finish(const TrD& d, LAS float* scr, int lane, const f32x4 (&v)[8], const float (&g)[8], bool wt) {
    const int nblk = d.N / 32, kb = d.item / nblk, nb = d.item % nblk, k0 = 64 * kb, n0 = 32 * nb, kr = lane >> 3, n4 = (lane & 7) * 4;
#pragma unroll
    for (int i = 0; i < 8; ++i) { LAS float* p = scr + (8 * i + kr) * 33 + n4; p[0] = v[i][0] * g[i]; p[1] = v[i][1] * g[i]; p[2] = v[i][2] * g[i]; p[3] = v[i][3] * g[i]; }
    asm volatile("s_waitcnt lgkmcnt(0)" ::: "memory");
    const int c = lane & 7;
#pragma unroll
    for (int j = 0; j < 4; ++j) { const int n = (lane >> 3) + 8 * j; const LAS float* s = scr + (8 * c) * 33 + n;
        u32x4 o; o.x = pk2(s[0 * 33], s[1 * 33]); o.y = pk2(s[2 * 33], s[3 * 33]); o.z = pk2(s[4 * 33], s[5 * 33]); o.w = pk2(s[6 * 33], s[7 * 33]);
        const int ng = n0 + n; const int row = d.mode == 0 ? ng : ((ng >> 7) * 256 + (ng & 127) + (d.mode == 2 ? 128 : 0));
        bst16w(mk_rsrc(d.WT), (unsigned)((row * d.K + k0 + 8 * c) * 2), o, wt); }
    asm volatile("s_waitcnt lgkmcnt(0)" ::: "memory");
}

struct Args { const float* in[21]; float* out; unsigned char* ws; int ph_lo, ph_hi; };
#define CAS __attribute__((address_space(4)))
struct KA { const CAS char* kp;
    DI const float* in(int i) const { return *(const float* const CAS*)(kp + 8 * i); }
    DI float* out() const { return *(float* const CAS*)(kp + 168); }
    DI unsigned char* ws() const { return *(unsigned char* const CAS*)(kp + 176); } };
static_assert(sizeof(Args) == 192, "Args layout");

DI void convert_set(const KA& a, LAS unsigned char* lds, int set, int ww, int nww, int wave, int lane) {
    asm volatile("" : "+v"(lane));
    unsigned char* ws = a.ws();
    LAS float* scr = (LAS float*)(lds + wave * 16384);
    const float* gains = a.in(6);
    constexpr int I_GU = (DM / 64) * (FF / 32), I_D = (FF / 64) * (DM / 32), I_IN0 = (DM / 64) * (NIN0 / 32), I_SQ = (DM / 64) * (DM / 32), I_IN1 = (DM / 64) * (NIN1 / 32), I_P = 2 * 4;
    auto mat_items = [&](int id) -> int { return id < 8 ? I_GU : id < 12 ? I_D : id == 12 ? I_IN0 : id == 14 ? I_IN1 : id < 16 ? I_SQ : I_P; };
    auto mat_desc = [&](int id, int item) -> TrD {
        if (id < 8) { const int lh = id & 3, up = id >> 2, l = lh >> 1, h = lh & 1;
            return TrD{a.in(up ? 9 : 8) + (size_t)lh * DM * FF, gains + (l * 3 + (h ? 2 : 0)) * DM, (bf16_t*)(ws + WS_WGU + lh * SZ_WGU), DM, FF, 1 + up, item}; }
        if (id < 12) { const int lh = id - 8; return TrD{a.in(10) + (size_t)lh * FF * DM, nullptr, (bf16_t*)(ws + WS_WD + lh * SZ_WD), FF, DM, 0, item}; }
        if (id == 12) return TrD{a.in(11), gains + 1 * DM, (bf16_t*)(ws + WS_WIN0), DM, NIN0, 0, item};
        if (id == 13) return TrD{a.in(12), nullptr, (bf16_t*)(ws + WS_WOUT0), DM, DM, 0, item};
        if (id == 14) return TrD{a.in(16), gains + 4 * DM, (bf16_t*)(ws + WS_WIN1), DM, NIN1, 0, item};
        if (id == 15) return TrD{a.in(20), nullptr, (bf16_t*)(ws + WS_WOUT1), DM, DM, 0, item};
        const int g = id - 16; return TrD{a.in(14) + (size_t)g * 128 * 128, nullptr, (bf16_t*)(ws + WS_WPT) + (size_t)g * 128 * 128, 128, 128, 0, item};
    };
    const unsigned long long lists[4] = { 0ull | (4ull << 5) | (16ull << 10) | (17ull << 15) | (18ull << 20) | (19ull << 25),
                                          8ull | (12ull << 5) | (13ull << 10),
                                          1ull | (5ull << 5) | (9ull << 10) | (2ull << 15) | (6ull << 20) | (10ull << 25) | (14ull << 30) | (15ull << 35),
                                          3ull | (7ull << 5) | (11ull << 10) };
    const int counts[4] = {6, 3, 8, 3};
    const unsigned long long lst = set == 0 ? lists[0] : set == 1 ? lists[1] : set == 2 ? lists[2] : lists[3];
    const int cnt = set == 0 ? counts[0] : set == 1 ? counts[1] : set == 2 ? counts[2] : counts[3];
    int total = 0;
    for (int k = 0; k < cnt; ++k) total += mat_items((int)((lst >> (5 * k)) & 31ull));
    auto decode = [&](int it) -> TrD { int r = it; int id = 0;
        for (int k = 0; k < cnt; ++k) { id = (int)((lst >> (5 * k)) & 31ull); const int n = mat_items(id); if (r < n) break; r -= n; }
        return mat_desc(id, r); };
    {
        f32x4 va[8], vb[8]; float ga[8], gb[8]; TrD d0, d1;
        int it = ww;
        if (it < total) { d0 = decode(it); tr_load(d0, lane, va, ga); }
#pragma unroll 1
        for (; it < total; it += 2 * nww) {
            const bool has1 = it + nww < total;
            if (has1) { d1 = decode(it + nww); tr_load(d1, lane, vb, gb); }
            tr_finish(d0, scr, lane, va, ga, true);
            if (!has1) break;
            const bool has2 = it + 2 * nww < total;
            if (has2) { d0 = decode(it + 2 * nww); tr_load(d0, lane, va, ga); }
            tr_finish(d1, scr, lane, vb, gb, true);
            if (!has2) break;
        }
    }
}
DI void prologue(const KA& a, LAS unsigned char* lds, int gw, int NGW, int wave, int lane) {
    unsigned char* ws = a.ws();
    convert_set(a, lds, 0, gw, NGW, wave, lane);
    const int gt = gw * 64 + lane, NGT = NGW * 64;
    { const float* wsp = a.in(18); bf16_t* wst = (bf16_t*)(ws + WS_WST);
      for (int i = gt; i < 4 * 128 * 128; i += NGT) { const int s = i & 127, t = (i >> 7) & 127; wst[i] = f2bf(s <= t ? wsp[i] : 0.f); } }
    if (gt < 8 * 128) { const int h = gt >> 7, n = gt & 127; int bk = n;
        if (n >= 16) { const float nf = (float)n; int lg = 16 + (int)(logf(nf / 16.0f) / 2.0794415416798357f * 16.0f); bk = lg < 31 ? lg : 31; }
        ((float*)(ws + WS_BIAS))[gt] = a.in(5)[bk * 8 + h]; }
    bf16_t* XB = (bf16_t*)(ws + WS_XB); float* ssp0 = (float*)(ws + WS_SSP);
    {   const float* xp = a.in(0); const float* xs = a.in(1) - (size_t)MP * DM;
        auto ldrow = [&](int m, f32x4 (&v)[4]) { const f32x4* xr = (const f32x4*)((m < MP ? xp : xs) + (size_t)m * DM) + lane;
#pragma unroll
            for (int j = 0; j < 4; ++j) v[j] = __builtin_nontemporal_load(&xr[64 * j]); };
        auto fin = [&](int m, const f32x4 (&v)[4]) { float s = 0.f;
#pragma unroll
            for (int j = 0; j < 4; ++j) s += (v[j].x * v[j].x + v[j].y * v[j].y) + (v[j].z * v[j].z + v[j].w * v[j].w);
            s = wave_sum(s);
            const rsrc_t rxb = mk_rsrc(XB); const unsigned o8 = (unsigned)m * (DM * 2) + (unsigned)lane * 8u;
#pragma unroll
            for (int j = 0; j < 4; ++j) { u32x2 w; w.x = pk2(v[j].x, v[j].y); w.y = pk2(v[j].z, v[j].w); __builtin_amdgcn_raw_buffer_store_b64(w, rxb, o8 + 512u * j, 0, 16); }
            if (lane == 0) ssp0[m] = s * 0.0625f; };
        f32x4 v0[4], v1[4], v2[4], v3[4], v4[4];
        static_assert(MROWS == 8 * GRID * 8 + GRID * 2, "prologue row split");
#pragma unroll 1
        for (int m = gw; m < 8 * NGW; m += 4 * NGW) {
            const bool ex = m >= 4 * NGW && gw >= 6 * GRID; const int mx = 8 * NGW + (gw - 6 * GRID);
            ldrow(m, v0); ldrow(m + NGW, v1); ldrow(m + 2 * NGW, v2); ldrow(m + 3 * NGW, v3); if (ex) ldrow(mx, v4);
            fin(m, v0); fin(m + NGW, v1); fin(m + 2 * NGW, v2); fin(m + 3 * NGW, v3); if (ex) fin(mx, v4);
        }
    }
}

DI void state_copies(const KA& a, int wt, int nwt) {
    asm volatile("" : "+v"(wt));
    float* out = a.out(); const float* sk = a.in(2); const float* sv = a.in(3); const float* sp = a.in(4);
#pragma unroll 4
    for (int i4 = wt; i4 < 128 * 3968; i4 += nwt) { const int b = i4 / 3968, rem = i4 - b * 3968; const size_t o = (size_t)b * 16384 + (size_t)rem * 4;
        __builtin_nontemporal_store(__builtin_nontemporal_load((const f32x4*)(sk + o + 512)), (f32x4*)(out + O_KS + o)); __builtin_nontemporal_store(__builtin_nontemporal_load((const f32x4*)(sv + o + 512)), (f32x4*)(out + O_VS + o)); }
#pragma unroll 4
    for (int i4 = wt; i4 < 128 * 1408; i4 += nwt) { const int b = i4 / 1408, rem = i4 - b * 1408; const size_t o = (size_t)b * 7680 + (size_t)rem * 4;
        __builtin_nontemporal_store(__builtin_nontemporal_load((const f32x4*)(sp + o + 2048)), (f32x4*)(out + O_PS + o)); }
}

DI int crow(int r, int hi) { return (r & 3) + 8 * (r >> 2) + 4 * hi; }
#define MFMA32(a, b, c) __builtin_amdgcn_mfma_f32_32x32x16_bf16((a), (b), (c), 0, 0, 0)
constexpr int KS_STRIDE = 144, VT_STRIDE = 520, KS_BYTES = 256 * KS_STRIDE;

DI float softmax5(f32x16 (&sc)[5], float sink) {
    float mx = NEGV;
#pragma unroll
    for (int t = 0; t < 5; ++t)
#pragma unroll
        for (int r = 0; r < 16; ++r) mx = fmaxf(mx, sc[t][r]);
    mx = max32(mx);
    const float m = fmaxf(mx, sink);
    float l = 0.f;
#pragma unroll
    for (int t = 0; t < 5; ++t)
#pragma unroll
        for (int r = 0; r < 16; ++r) { const float p = fexp(sc[t][r] - m); sc[t][r] = p; l += p; }
    l = add32(l);
    l += fexp(sink - m);
    return 1.0f / l;
}
DI bf16x8 pack_step(const f32x16& x, int s) {
    u32x4 p; p.x = pk2(x[8 * s], x[8 * s + 1]); p.y = pk2(x[8 * s + 2], x[8 * s + 3]); p.z = pk2(x[8 * s + 4], x[8 * s + 5]); p.w = pk2(x[8 * s + 6], x[8 * s + 7]);
    return __builtin_bit_cast(bf16x8, p);
}

constexpr int BT_OFF = KS_BYTES + 64 * VT_STRIDE;
DI void fill_bias_table(LAS float* T, const float* bT, int lane) {
#pragma unroll
    for (int i = 0; i < 4; ++i) { const int k = lane + 64 * i, dist = 159 - k; if (k < 196) T[k] = (dist >= 0 && dist < 128) ? bT[dist & 127] : NEGV; }
}
DI void attn_prompt_item(int item, int tid, LAS unsigned char* lds, const bf16_t* Q, const bf16_t* Kb, const bf16_t* Vb, bf16_t* CAT, const float* biasT, const float* sinks) {
    asm volatile("" : "+v"(tid));
    const int lane = tid & 63, wid = __builtin_amdgcn_readfirstlane(tid >> 6), r32 = lane & 31, hi = lane >> 5;
    const int kvh = item & 1, j = (item >> 1) & 15, b = item >> 5;
    const int rowq0 = b * SEQ + j * 128, rowk0 = rowq0 - 128;
    LAS unsigned char* KS = lds; LAS unsigned char* VT = lds + KS_BYTES;
    const int g = wid >> 1, qh = wid & 1, hq = kvh * 4 + g;
    LAS float* T = (LAS float*)(lds + BT_OFF) + wid * 256;
    fill_bias_table(T, biasT + hq * 128, lane);
    {
        const int ch = tid & 7, key0 = tid >> 3; u32x4 kq[4], vq[4];
#pragma unroll
        for (int k = 0; k < 4; ++k) { const int key = key0 + 64 * k; const bool ok = (j > 0) || key >= 128; const size_t o = (size_t)(ok ? rowk0 + key : rowq0 + (key & 127)) * 128 + kvh * 64 + ch * 8;
            kq[k] = *(const u32x4*)(Kb + o); vq[k] = *(const u32x4*)(Vb + o); }
#pragma unroll
        for (int k = 0; k < 4; ++k) { const int key = key0 + 64 * k; const bool ok = (j > 0) || key >= 128;
            const u32x4 kv = ok ? kq[k] : (u32x4){0u, 0u, 0u, 0u}, vv = ok ? vq[k] : (u32x4){0u, 0u, 0u, 0u};
            *(LAS u32x4*)(KS + key * KS_STRIDE + ch * 16) = kv;
#pragma unroll
            for (int i = 0; i < 4; ++i) { const unsigned w = vv[i];
                *(LAS unsigned short*)(VT + (ch * 8 + 2 * i) * VT_STRIDE + key * 2) = (unsigned short)(w & 0xffffu);
                *(LAS unsigned short*)(VT + (ch * 8 + 2 * i + 1) * VT_STRIDE + key * 2) = (unsigned short)(w >> 16); } }
    }
    __syncthreads();
    const float sink = sinks[hq];
    const LAS float* Tl = T + (31 - r32 + 4 * hi);
#pragma unroll 1
    for (int qt = 0; qt < 2; ++qt) {
        const int qo = 64 * qh + 32 * qt;
        const LAS unsigned char* kbase = KS + (qo + r32) * KS_STRIDE + hi * 16;
        const LAS unsigned char* vbase = VT + r32 * VT_STRIDE + (qo + 4 * hi) * 2;
        bf16x8 qf[4];
#pragma unroll
        for (int s = 0; s < 4; ++s) qf[s] = *(const bf16x8*)(Q + (size_t)(rowq0 + qo + r32) * 512 + hq * 64 + 16 * s + 8 * hi);
        f32x16 sc[5];
#pragma unroll
        for (int t = 0; t < 5; ++t) {
            f32x16 acc; bf16x8 kf[4];
#pragma unroll
            for (int r = 0; r < 16; ++r) acc[r] = Tl[32 * t + (r & 3) + 8 * (r >> 2)];
#pragma unroll
            for (int s = 0; s < 4; ++s) kf[s] = *(const LAS bf16x8*)(kbase + t * 32 * KS_STRIDE + s * 32);
#pragma unroll
            for (int s = 0; s < 4; ++s) acc = MFMA32(kf[s], qf[s], acc);
            sc[t] = acc;
        }
        if (j == 0) {
            const int lim = qo + r32, d0 = 128 + r32 - 4 * hi;
#pragma unroll
            for (int t = 0; t < 5; ++t)
#pragma unroll
                for (int r = 0; r < 16; ++r) { const int dist = d0 - (32 * t + (r & 3) + 8 * (r >> 2)); if (dist > lim) sc[t][r] = NEGV; }
        }
        const float linv = softmax5(sc, sink);
        f32x16 o0 = {}, o1 = {};
#pragma unroll
        for (int t = 0; t < 5; ++t)
#pragma unroll
            for (int ks = 0; ks < 2; ++ks) {
                const bf16x8 pa = pack_step(sc[t], ks); const LAS unsigned char* vp = vbase + (32 * t + 16 * ks) * 2;
                { const u32x2 lo = *(const LAS u32x2*)(vp), h2 = *(const LAS u32x2*)(vp + 16);
                  const u32x4 vb = {lo.x, lo.y, h2.x, h2.y}; o0 = MFMA32(pa, __builtin_bit_cast(bf16x8, vb), o0); }
                { const u32x2 lo = *(const LAS u32x2*)(vp + 32 * VT_STRIDE), h2 = *(const LAS u32x2*)(vp + 32 * VT_STRIDE + 16);
                  const u32x4 vb = {lo.x, lo.y, h2.x, h2.y}; o1 = MFMA32(pa, __builtin_bit_cast(bf16x8, vb), o1); }
            }
#pragma unroll
        for (int r = 0; r < 16; ++r) { const int qq = crow(r, hi); const float li = __shfl(linv, qq);
            bf16_t* op = CAT + (size_t)(rowq0 + qo + qq) * DM + hq * 64 + r32;
            op[0] = f2bf(o0[r] * li); op[32] = f2bf(o1[r] * li); }
    }
    __syncthreads();
}

constexpr int SKS_OFF = 86016, SVT_STRIDE = 328, SVT_OFF = SKS_OFF + 160 * KS_STRIDE;
static_assert(SVT_OFF + 64 * SVT_STRIDE <= RING_BYTES && BT_OFF + 12 * 1024 <= SKS_OFF, "sample attention LDS map");
DI void attn_sample_item(int item, int tid, LAS unsigned char* lds, const bf16_t* Q, const bf16_t* Kb, const bf16_t* Vb, const float* sk, const float* sv, bf16_t* CAT, const float* biasT, const float* sinks) {
    asm volatile("" : "+v"(tid));
    const int lane = tid & 63, wid = __builtin_amdgcn_readfirstlane(tid >> 6), r32 = lane & 31, hi = lane >> 5, kvh = item & 1, b = item >> 1;
    LAS unsigned char* KS = lds + SKS_OFF; LAS unsigned char* VT = lds + SVT_OFF;
    LAS float* T4 = (LAS float*)(lds + BT_OFF) + 8 * 256;
    if (wid < 4) fill_bias_table(T4 + wid * 256, biasT + (kvh * 4 + wid) * 128, lane);
    {
        const int ch = tid & 7, key0 = tid >> 3; f32x4 kf[2][2], vf[2][2]; u32x4 kn = (u32x4){0u, 0u, 0u, 0u}, vn = kn;
#pragma unroll
        for (int k = 0; k < 2; ++k) { const size_t o = ((size_t)(b * 128 + key0 + 64 * k) * 2 + kvh) * 64 + ch * 8;
            kf[k][0] = *(const f32x4*)(sk + o); kf[k][1] = *(const f32x4*)(sk + o + 4); vf[k][0] = *(const f32x4*)(sv + o); vf[k][1] = *(const f32x4*)(sv + o + 4); }
        if (key0 < 4) { const size_t o = (size_t)(MP + b * 4 + key0) * 128 + kvh * 64 + ch * 8; kn = *(const u32x4*)(Kb + o); vn = *(const u32x4*)(Vb + o); }
#pragma unroll
        for (int k = 0; k < 3; ++k) { const int key = key0 + 64 * k; if (k == 2 && key0 >= 32) break;
            const u32x4 kv = k < 2 ? (u32x4){pk2(kf[k & 1][0][0], kf[k & 1][0][1]), pk2(kf[k & 1][0][2], kf[k & 1][0][3]), pk2(kf[k & 1][1][0], kf[k & 1][1][1]), pk2(kf[k & 1][1][2], kf[k & 1][1][3])} : kn;
            const u32x4 vv = k < 2 ? (u32x4){pk2(vf[k & 1][0][0], vf[k & 1][0][1]), pk2(vf[k & 1][0][2], vf[k & 1][0][3]), pk2(vf[k & 1][1][0], vf[k & 1][1][1]), pk2(vf[k & 1][1][2], vf[k & 1][1][3])} : vn;
            *(LAS u32x4*)(KS + key * KS_STRIDE + ch * 16) = kv;
#pragma unroll
            for (int i = 0; i < 4; ++i) { const unsigned w = vv[i];
                *(LAS unsigned short*)(VT + (ch * 8 + 2 * i) * SVT_STRIDE + key * 2) = (unsigned short)(w & 0xffffu);
                *(LAS unsigned short*)(VT + (ch * 8 + 2 * i + 1) * SVT_STRIDE + key * 2) = (unsigned short)(w >> 16); } }
    }
    __syncthreads();
    if (wid != 0) return;
    const int c = r32, g = (c >> 2) & 3, t = c & 3, hq = kvh * 4 + g; const bool cval = c < 16;
    const LAS float* Tl = T4 + g * 256 + (31 - t + 4 * hi);
    const LAS unsigned char* kbase = KS + r32 * KS_STRIDE + hi * 16;
    const LAS unsigned char* vbase = VT + r32 * SVT_STRIDE + (4 * hi) * 2;
    bf16x8 qf[4];
#pragma unroll
    for (int s = 0; s < 4; ++s) { qf[s] = (bf16x8){0, 0, 0, 0, 0, 0, 0, 0}; if (cval) qf[s] = *(const bf16x8*)(Q + (size_t)(MP + b * 4 + t) * 512 + hq * 64 + 16 * s + 8 * hi); }
    f32x16 sc[5];
#pragma unroll
    for (int kt = 0; kt < 5; ++kt) {
        f32x16 acc; bf16x8 kf[4];
#pragma unroll
        for (int r = 0; r < 16; ++r) acc[r] = Tl[32 * kt + (r & 3) + 8 * (r >> 2)];
#pragma unroll
        for (int s = 0; s < 4; ++s) kf[s] = *(const LAS bf16x8*)(kbase + kt * 32 * KS_STRIDE + s * 32);
#pragma unroll
        for (int s = 0; s < 4; ++s) acc = MFMA32(kf[s], qf[s], acc);
        sc[kt] = acc;
    }
    const float linv = softmax5(sc, sinks[hq]);
    f32x16 o0 = {}, o1 = {};
#pragma unroll
    for (int kt = 0; kt < 5; ++kt)
#pragma unroll
        for (int ks = 0; ks < 2; ++ks) {
            const bf16x8 pa = pack_step(sc[kt], ks); const LAS unsigned char* vp = vbase + (32 * kt + 16 * ks) * 2;
            { const u32x2 lo = *(const LAS u32x2*)(vp), h2 = *(const LAS u32x2*)(vp + 16);
              const u32x4 vb = {lo.x, lo.y, h2.x, h2.y}; o0 = MFMA32(pa, __builtin_bit_cast(bf16x8, vb), o0); }
            { const u32x2 lo = *(const LAS u32x2*)(vp + 32 * SVT_STRIDE), h2 = *(const LAS u32x2*)(vp + 32 * SVT_STRIDE + 16);
              const u32x4 vb = {lo.x, lo.y, h2.x, h2.y}; o1 = MFMA32(pa, __builtin_bit_cast(bf16x8, vb), o1); }
        }
#pragma unroll
    for (int r = 0; r < 8; ++r) { const int cc = crow(r, hi); const float li = __shfl(linv, cc); const int gg = cc >> 2, tt = cc & 3;
        bf16_t* op = CAT + (size_t)(MP + b * 4 + tt) * DM + (kvh * 4 + gg) * 64 + r32;
        op[0] = f2bf(o0[r] * li); op[32] = f2bf(o1[r] * li); }
}

constexpr int PD_STRIDE = 272, PD_BYTES = 32 * PD_STRIDE;
template <int W> DI void pool_fill(int row0, int g, LAS unsigned char* dl, const bf16_t* UP, const float* spool, int lane) {
    const int cl = 2 * lane, cg = g * 128 + cl;
    if (row0 < MP) {
        const int tpos0 = row0 & (SEQ - 1);
        constexpr int NR = 31 + W;
        float z0[NR], z1[NR];
#pragma unroll
        for (int q = 0; q < NR; ++q) { const int d = q - (W - 1); const bool ok = (tpos0 + d) >= 0; const int rr = ok ? row0 + d : row0;
            const unsigned u = *(const unsigned*)(UP + (size_t)rr * 512 + cg); z0[q] = ok ? bflo(u) : 0.f; z1[q] = ok ? bfhi(u) : 0.f; }
        float s0 = 0.f, s1 = 0.f;
#pragma unroll
        for (int q = 0; q < W - 1; ++q) { s0 += z0[q]; s1 += z1[q]; }
#pragma unroll
        for (int i = 0; i < 32; ++i) { s0 += z0[W - 1 + i]; s1 += z1[W - 1 + i]; const int c = tpos0 + i + 1; const float inv = (c < W) ? 1.0f / (float)c : 1.0f / (float)W;
            *(LAS unsigned*)(dl + i * PD_STRIDE + cl * 2) = pk2(s0 * inv - z0[W - 1 + i], s1 * inv - z1[W - 1 + i]); s0 -= z0[i]; s1 -= z1[i]; }
    } else {
        const int b0 = (row0 - MP) >> 2;
#pragma unroll 1
        for (int bb = 0; bb < 8; ++bb) { const int bq = b0 + bb;
            constexpr int NZ = W + 3; float z0[NZ], z1[NZ];
#pragma unroll
            for (int q = 0; q < NZ; ++q) { const int j = 16 - W + q;
                if (j < 15) { const f32x2 f = *(const f32x2*)(spool + ((size_t)bq * 15 + j) * 512 + cg); z0[q] = f.x; z1[q] = f.y; }
                else { const unsigned u = *(const unsigned*)(UP + (size_t)(MP + bq * 4 + j - 15) * 512 + cg); z0[q] = bflo(u); z1[q] = bfhi(u); } }
            float s0 = 0.f, s1 = 0.f;
#pragma unroll
            for (int q = 0; q < W - 1; ++q) { s0 += z0[q]; s1 += z1[q]; }
#pragma unroll
            for (int t = 0; t < 4; ++t) { s0 += z0[W - 1 + t]; s1 += z1[W - 1 + t];
                *(LAS unsigned*)(dl + (bb * 4 + t) * PD_STRIDE + cl * 2) = pk2(s0 * (1.0f / W) - z0[W - 1 + t], s1 * (1.0f / W) - z1[W - 1 + t]); s0 -= z0[t]; s1 -= z1[t]; }
        }
    }
}
DI void pool_item(int item, int nt_lo, int nt_hi, LAS unsigned char* dl, const bf16_t* UP, const float* spool, const bf16_t* WPT, const float* pscale, bf16_t* CAT, int lane) {
    asm volatile("" : "+v"(lane));
    const int g = item & 3, blk = item >> 2, row0 = blk * 32, r32 = lane & 31, hi = lane >> 5;
    if (g == 0) pool_fill<2>(row0, g, dl, UP, spool, lane); else if (g == 1) pool_fill<4>(row0, g, dl, UP, spool, lane);
    else if (g == 2) pool_fill<8>(row0, g, dl, UP, spool, lane); else pool_fill<16>(row0, g, dl, UP, spool, lane);
    asm volatile("s_waitcnt lgkmcnt(0)" ::: "memory");
    f32x16 acc[4] = {{}, {}, {}, {}};
    if (nt_hi - nt_lo == 4) {
        bf16x8 wb[8][4];
#pragma unroll
        for (int s = 0; s < 8; ++s)
#pragma unroll
            for (int nt = 0; nt < 4; ++nt) wb[s][nt] = *(const bf16x8*)(WPT + ((size_t)g * 128 + 32 * nt + r32) * 128 + 16 * s + 8 * hi);
#pragma unroll
        for (int s = 0; s < 8; ++s) { const bf16x8 af = *(const LAS bf16x8*)(dl + r32 * PD_STRIDE + (16 * s + 8 * hi) * 2);
#pragma unroll
            for (int nt = 0; nt < 4; ++nt) acc[nt] = MFMA32(af, wb[s][nt], acc[nt]); }
    } else {
        bf16x8 wb[8];
#pragma unroll
        for (int s = 0; s < 8; ++s) wb[s] = *(const bf16x8*)(WPT + ((size_t)g * 128 + 32 * nt_lo + r32) * 128 + 16 * s + 8 * hi);
        f32x16 a1 = {};
#pragma unroll
        for (int s = 0; s < 8; ++s) { const bf16x8 af = *(const LAS bf16x8*)(dl + r32 * PD_STRIDE + (16 * s + 8 * hi) * 2); a1 = MFMA32(af, wb[s], a1); }
#pragma unroll
        for (int nt = 0; nt < 4; ++nt) if (nt == nt_lo) acc[nt] = a1;
    }
#pragma unroll
    for (int nt = 0; nt < 4; ++nt) if (nt >= nt_lo && nt < nt_hi) { const float scl = pscale[g * 128 + 32 * nt + r32];
#pragma unroll
        for (int r = 0; r < 16; ++r) CAT[(size_t)(row0 + crow(r, hi)) * DM + 512 + g * 128 + 32 * nt + r32] = f2bf(acc[nt][r] * scl); }
    asm volatile("s_waitcnt lgkmcnt(0)" ::: "memory");
}

DI void mix0_phase(const KA& a, LAS unsigned char* lds, int tid, int bid, int gw, int NGW, int wave, int lane) {
    unsigned char* ws = a.ws();
    const bf16_t *Q = (const bf16_t*)(ws + WS_Q), *Kb = (const bf16_t*)(ws + WS_K), *Vb = (const bf16_t*)(ws + WS_V), *UP = (const bf16_t*)(ws + WS_UP);
    bf16_t* CAT = (bf16_t*)(ws + WS_CAT); const float* biasT = (const float*)(ws + WS_BIAS);
#ifndef MIXM
#define MIXM 15
#endif
    if (MIXM & 1) for (int it = bid; it < 256; it += GRID) attn_prompt_item(it, tid, lds, Q, Kb, Vb, CAT, biasT, a.in(13));
    if (MIXM & 2) for (int it = bid; it < 256; it += GRID) attn_sample_item(it, tid, lds, Q, Kb, Vb, a.in(2), a.in(3), CAT, biasT, a.in(13));
    if (MIXM & 4) { pool_item(gw, 0, 4, lds + wave * PD_BYTES, UP, a.in(4), (const bf16_t*)(ws + WS_WPT), a.in(15), CAT, lane);
        if (wave == 1) pool_item(2048 + (bid >> 2), bid & 3, (bid & 3) + 1, lds + wave * PD_BYTES, UP, a.in(4), (const bf16_t*)(ws + WS_WPT), a.in(15), CAT, lane); }
    if (!(MIXM & 8)) return;
    asm volatile("" : "+v"(lane));
    float* out = a.out(); const int gt = gw * 64 + lane; constexpr int NGT = GRID * 512;
    auto ld4 = [](const bf16_t* p) { const u32x2 w = *(const u32x2*)p; return (f32x4){bflo(w.x), bfhi(w.x), bflo(w.y), bfhi(w.y)}; };
    static_assert(NGT >= 128 * 4 * 128, "one step per copy");
    const bool p1 = gt < 128 * 4 * 32, p2 = gt < 128 * 4 * 128, p3 = gt < 8 * 128 * 32, p4 = gt < 8 * 15 * 128;
    const int j1 = p1 ? gt : 0, j2 = p2 ? gt : 0, j3 = p3 ? gt : 0, j4 = p4 ? gt : 0;
    const int c1 = (j1 & 31) * 4, t1 = (j1 >> 5) & 3, b1 = j1 >> 7; const size_t r1 = (size_t)(MP + b1 * 4 + t1) * 128 + c1, o1 = (size_t)(b1 * 128 + 124 + t1) * 128 + c1;
    const int c2 = (j2 & 127) * 4, t2 = (j2 >> 7) & 3, b2 = j2 >> 9; const size_t r2 = (size_t)(MP + b2 * 4 + t2) * 512 + c2, o2 = (size_t)(b2 * 15 + 11 + t2) * 512 + c2;
    const int i3 = j3 * 4, c3 = i3 & 127, w3 = (i3 >> 7) & 127, b3 = i3 >> 14; const size_t r3 = (size_t)(b3 * SEQ + 1920 + w3) * 128 + c3;
    const int i4 = j4 * 4, c4 = i4 & 511, q4 = i4 >> 9, ii4 = q4 % 15, b4 = q4 / 15; const size_t r4 = (size_t)(b4 * SEQ + 2033 + ii4) * 512 + c4;
    const f32x4 a1 = ld4(Kb + r1), a2 = ld4(Vb + r1), a3 = ld4(UP + r2), a4 = ld4(Kb + r3), a5 = ld4(Vb + r3), a6 = ld4(UP + r4);
    if (p1) { __builtin_nontemporal_store(a1, (f32x4*)(out + O_KS + o1)); __builtin_nontemporal_store(a2, (f32x4*)(out + O_VS + o1)); }
    if (p2) __builtin_nontemporal_store(a3, (f32x4*)(out + O_PS + o2));
    if (p3) { __builtin_nontemporal_store(a4, (f32x4*)(out + O_KP + i3)); __builtin_nontemporal_store(a5, (f32x4*)(out + O_VP + i3)); }
    if (p4) __builtin_nontemporal_store(a6, (f32x4*)(out + O_PP + i4));
}

constexpr int VN_STRIDE = 528, VN_BYTES = 128 * VN_STRIDE;
DI void sgu_phase(const KA& a, LAS unsigned char* lds, int tid, int bid, int gw, int NGW, int wave, int lane) {
    unsigned char* ws = a.ws(); const int r32 = lane & 31, hi = lane >> 5;
    bf16_t* U = (bf16_t*)(ws + WS_U); const bf16_t* V1 = (const bf16_t*)(ws + WS_V1); const float* sspv = (const float*)(ws + WS_SSP + 5 * SZ_SSP);
    const float* gv = a.in(17); const float* bsp = a.in(19); const bf16_t* WST = (const bf16_t*)(ws + WS_WST);
    LAS float* rsv = (LAS float*)(lds + VN_BYTES);
    for (int item = bid; item < 512; item += GRID) {
        const int ch = item >> 2, g = item & 3, row0 = ch * 128;
        if (tid < 128) { float pp[16];
#pragma unroll
            for (int p = 0; p < 16; ++p) pp[p] = sspv[(size_t)p * MROWS + row0 + tid];
            float s = 0.f;
#pragma unroll
            for (int p = 0; p < 16; ++p) s += pp[p];
            rsv[tid] = rsqrtf(s * (1.0f / 1024.0f) + EPS); }
        __syncthreads();
        { const int c8 = tid & 31, s0 = tid >> 5;
            const f32x4 g0 = *(const f32x4*)(gv + g * 256 + c8 * 8), g1 = *(const f32x4*)(gv + g * 256 + c8 * 8 + 4);
            u32x4 vv[8];
#pragma unroll
            for (int k = 0; k < 8; ++k) vv[k] = *(const u32x4*)(V1 + (size_t)(row0 + s0 + 16 * k) * DM + g * 256 + c8 * 8);
#pragma unroll
            for (int k = 0; k < 8; ++k) { const u32x4 v = vv[k]; const int s = s0 + 16 * k; const float r = rsv[s];
                u32x4 o; o.x = pk2(bflo(v.x) * r * g0[0], bfhi(v.x) * r * g0[1]); o.y = pk2(bflo(v.y) * r * g0[2], bfhi(v.y) * r * g0[3]);
                o.z = pk2(bflo(v.z) * r * g1[0], bfhi(v.z) * r * g1[1]); o.w = pk2(bflo(v.w) * r * g1[2], bfhi(v.w) * r * g1[3]);
                *(LAS u32x4*)(lds + s * VN_STRIDE + c8 * 16) = o; } }
        bf16x8 wa[4][8];
#pragma unroll
        for (int tt = 0; tt < 4; ++tt)
#pragma unroll
            for (int ks = 0; ks < 8; ++ks) if (16 * ks <= 32 * tt + 31) wa[tt][ks] = *(const bf16x8*)(WST + ((size_t)g * 128 + 32 * tt + r32) * 128 + 16 * ks + 8 * hi);
        __syncthreads();
        f32x16 acc[4] = {{}, {}, {}, {}};
#pragma unroll
        for (int ks = 0; ks < 8; ++ks) {
            bf16x8 bfg;
#pragma unroll
            for (int jj = 0; jj < 8; ++jj) bfg[jj] = *(const LAS short*)(lds + (16 * ks + 8 * hi + jj) * VN_STRIDE + (32 * wave + r32) * 2);
#pragma unroll
            for (int tt = 0; tt < 4; ++tt) if (16 * ks <= 32 * tt + 31) acc[tt] = MFMA32(wa[tt][ks], bfg, acc[tt]);
        }
#pragma unroll
        for (int tt = 0; tt < 4; ++tt)
#pragma unroll
            for (int r = 0; r < 16; ++r) { const int t = 32 * tt + crow(r, hi); const size_t idx = (size_t)(row0 + t) * DM + g * 256 + 32 * wave + r32;
                acc[tt][r] = bf2f(U[idx]) * (acc[tt][r] + bsp[g * 128 + t]); }
#pragma unroll
        for (int tt = 0; tt < 4; ++tt)
#pragma unroll
            for (int r = 0; r < 16; ++r) { const int t = 32 * tt + crow(r, hi); const size_t idx = (size_t)(row0 + t) * DM + g * 256 + 32 * wave + r32;
                U[idx] = f2bf(acc[tt][r]); }
        __syncthreads();
    }
    const float* wsp = a.in(18); float* osv = a.out() + O_SV;
    for (int b = bid; b < DBATCH; b += GRID) {
        float rst[4];
#pragma unroll
        for (int s = 0; s < 4; ++s) { float q = (lane < 16) ? sspv[(size_t)lane * MROWS + MP + b * 4 + s] : 0.f; q = wave_sum(q); rst[s] = rsqrtf(q * (1.0f / 1024.0f) + EPS); }
        for (int cc = 2 * wave; cc < 2 * wave + 2; ++cc) { const int c = cc * 64 + lane, g = c >> 8; const float gc = gv[c]; float vn[4], uu[4], bb[4], ww[4][4];
#pragma unroll
            for (int s = 0; s < 4; ++s) { vn[s] = bf2f(V1[(size_t)(MP + b * 4 + s) * DM + c]); uu[s] = bf2f(U[(size_t)(MP + b * 4 + s) * DM + c]); bb[s] = bsp[g * 128 + s];
#pragma unroll
                for (int t = 0; t < 4; ++t) ww[t][s] = (s <= t) ? wsp[((size_t)g * 128 + t) * 128 + s] : 0.f; }
#pragma unroll
            for (int s = 0; s < 4; ++s) vn[s] = vn[s] * rst[s] * gc;
#pragma unroll
            for (int s = 0; s < 4; ++s) __builtin_nontemporal_store(vn[s], osv + (size_t)(b * 4 + s) * DM + c);
#pragma unroll
            for (int t = 0; t < 4; ++t) { float mx = bb[t];
#pragma unroll
                for (int s = 0; s < 4; ++s) if (s <= t) mx += ww[t][s] * vn[s];
                U[(size_t)(MP + b * 4 + t) * DM + c] = f2bf(uu[t] * mx); } }
    }
}

DI void final_phase(const KA& a, int gw, int NGW, int lane) {
    const float* fg = a.in(7); const bf16_t* XB = (const bf16_t*)(a.ws() + WS_XB); float* out = a.out();
    auto ld = [&](int m, u32x4 (&x)[2]) { const u32x4* xr = (const u32x4*)(XB + (size_t)m * DM) + lane; x[0] = xr[0]; x[1] = xr[64]; };
    auto fin = [&](int m, const u32x4 (&x)[2]) { f32x4 v[4]; float s = 0.f;
#pragma unroll
        for (int j = 0; j < 2; ++j) { v[2 * j] = (f32x4){bflo(x[j].x), bfhi(x[j].x), bflo(x[j].y), bfhi(x[j].y)}; v[2 * j + 1] = (f32x4){bflo(x[j].z), bfhi(x[j].z), bflo(x[j].w), bfhi(x[j].w)}; }
#pragma unroll
        for (int j = 0; j < 4; ++j) s += (v[j].x * v[j].x + v[j].y * v[j].y) + (v[j].z * v[j].z + v[j].w * v[j].w);
        const float r = rsqrtf(wave_sum(s) * (1.0f / DM) + EPS);
#pragma unroll
        for (int j = 0; j < 4; ++j) { const int e = (j >> 1) * 512 + lane * 8 + (j & 1) * 4; const f32x4 gg = *(const f32x4*)(fg + e); *(f32x4*)(out + (size_t)m * DM + e) = v[j] * r * gg; } };
    u32x4 x0[2], x1[2], x2[2], x3[2];
#pragma unroll 1
    for (int m = gw; m < MROWS; m += 4 * NGW) {
        const bool h1 = m + NGW < MROWS, h2 = m + 2 * NGW < MROWS, h3 = m + 3 * NGW < MROWS;
        ld(m, x0); if (h1) ld(m + NGW, x1); if (h2) ld(m + 2 * NGW, x2); if (h3) ld(m + 3 * NGW, x3);
        fin(m, x0); if (h1) fin(m + NGW, x1); if (h2) fin(m + 2 * NGW, x2); if (h3) fin(m + 3 * NGW, x3);
    }
}

struct SideResid {
    const float* in; bf16_t* XB; float* ssp; float s;
    float* Y; const float* gain; float* xs; unsigned* cnt;
    DI void pre(int, int, LAS float*) const {}
    DI void operator()(f32x4 acc, int row, int col, int cb, int lr, int tid, const LAS float*) const {
        const size_t off = (size_t)row * DM + col;
        f32x4 a; if (in) a = *(const f32x4*)(in + off); else { const u32x2 x = *(const u32x2*)(XB + off); a = (f32x4){bflo(x.x), bfhi(x.x), bflo(x.y), bfhi(x.y)}; }
        a = a + acc * s;
        if (Y) {
            float q = (a[0] * a[0] + a[1] * a[1]) + (a[2] * a[2] + a[3] * a[3]);
            q += __shfl_xor(q, 1); q += __shfl_xor(q, 2); q += __shfl_xor(q, 4); q += __shfl_xor(q, 8);
            float* slot = xs + (size_t)(row - MP) * 16; unsigned* c = cnt + 64 * ((row - MP) >> 5);
            if ((tid & 15) == 0) st4_wt(slot + cb, q);
            asm volatile("s_waitcnt vmcnt(0)" ::: "memory"); __syncthreads();
            if (tid == 0) { __hip_atomic_fetch_add(c, 1u, __ATOMIC_RELAXED, __HIP_MEMORY_SCOPE_AGENT); wait_count(c, 16u); }
            __syncthreads();
            const f32x4 p0 = *(const f32x4*)(slot), p1 = *(const f32x4*)(slot + 4), p2 = *(const f32x4*)(slot + 8), p3 = *(const f32x4*)(slot + 12);
            const float tot = ((p0[0] + p0[1]) + (p0[2] + p0[3])) + ((p1[0] + p1[1]) + (p1[2] + p1[3])) + ((p2[0] + p2[1]) + (p2[2] + p2[3])) + ((p3[0] + p3[1]) + (p3[2] + p3[3]));
            *(f32x4*)(Y + off) = a * rsqrtf(tot * (1.0f / DM) + EPS) * *(const f32x4*)(gain + col);
            return;
        }
        u32x2 w; w.x = pk2(a[0], a[1]); w.y = pk2(a[2], a[3]); *(u32x2*)(XB + off) = w;
        float q = (a[0] * a[0] + a[1] * a[1]) + (a[2] * a[2] + a[3] * a[3]);
        q += __shfl_xor(q, 1); q += __shfl_xor(q, 2); q += __shfl_xor(q, 4); q += __shfl_xor(q, 8);
        if ((tid & 15) == 0) ssp[(size_t)cb * MROWS + row] = q;
    }
};
struct SideGeluUV {
    const float* ssp_in; bf16_t *U, *V1; float* ssp;
    DI void pre(int row0, int tid, LAS float* rl) const { if (tid < 32) { float pp[16];
#pragma unroll
            for (int p = 0; p < 16; ++p) pp[p] = ssp_in[(size_t)p * MROWS + row0 + tid];
            float s = 0.f;
#pragma unroll
            for (int p = 0; p < 16; ++p) s += pp[p];
            rl[tid] = rsqrtf(s * (1.0f / DM) + EPS); } }
    DI void operator()(f32x4 acc, int row, int col, int cb, int lr, int tid, const LAS float* rl) const {
        const float r = rl[lr]; f32x4 v; float q = 0.f;
#pragma unroll
        for (int i = 0; i < 4; ++i) { v[i] = gelu_tanh(acc[i] * r); q += v[i] * v[i]; }
        u32x2 w; w.x = pk2(v[0], v[1]); w.y = pk2(v[2], v[3]);
        if (col < 1024) *(u32x2*)(U + (size_t)row * DM + col) = w;
        else { *(u32x2*)(V1 + (size_t)row * DM + col - 1024) = w;
            q += __shfl_xor(q, 1); q += __shfl_xor(q, 2); q += __shfl_xor(q, 4); q += __shfl_xor(q, 8);
            if ((tid & 15) == 0) ssp[(size_t)(cb - 16) * MROWS + row] = q; }
    }
};
constexpr int SG_STRIDE = 528, SG_STAGE = 96 * SG_STRIDE;
template <class SEpi> DI void side_gemm(LAS unsigned char* lds, int tid, int bid, const bf16_t* A, const bf16_t* Bt, int N, int K, const SEpi& E) {
    asm volatile("" : "+v"(tid));
    const int lane = tid & 63, wid = __builtin_amdgcn_readfirstlane(tid >> 6), r32 = lane & 31, hi = lane >> 5;
    const int ncb = N >> 6, npieces = 16 * ncb, nc = K >> 8;
    LAS float* part = (LAS float*)lds + wid * 2048; LAS float* rl = (LAS float*)(lds + 2 * SG_STAGE);
#pragma unroll 1
    for (int p = bid; p < npieces; p += GRID) {
        const int cb = p % ncb, rb = p / ncb, row0 = MP + rb * 32, col0 = cb * 64;
        E.pre(row0, tid, rl);
        const bf16_t* src[6]; int dst[6];
#pragma unroll
        for (int i = 0; i < 6; ++i) { const int u = tid + 512 * i, row = u >> 5, c16 = u & 31;
            src[i] = (row < 32 ? A + (size_t)(row0 + row) * K : Bt + (size_t)(col0 + row - 32) * K) + c16 * 8; dst[i] = row * SG_STRIDE + c16 * 16; }
        u32x4 ra[6], rb2[6];
#define SG_LOAD(R, ch) do { _Pragma("unroll") for (int i = 0; i < 6; ++i) R[i] = *(const u32x4*)(src[i] + (ch) * 256); } while (0)
#define SG_WRITE(R, st) do { _Pragma("unroll") for (int i = 0; i < 6; ++i) *(LAS u32x4*)(lds + (st) * SG_STAGE + dst[i]) = R[i]; } while (0)
#define SG_COMP(st) do { _Pragma("unroll") for (int s2 = 0; s2 < 2; ++s2) { const int koff = (16 * (2 * wid + s2) + 8 * hi) * 2; const LAS unsigned char* sp_ = lds + (st) * SG_STAGE; \
            const bf16x8 a = *(const LAS bf16x8*)(sp_ + r32 * SG_STRIDE + koff), x0 = *(const LAS bf16x8*)(sp_ + (32 + r32) * SG_STRIDE + koff), x1 = *(const LAS bf16x8*)(sp_ + (64 + r32) * SG_STRIDE + koff); \
            c0 = MFMA32(a, x0, c0); c1 = MFMA32(a, x1, c1); } } while (0)
        SG_LOAD(ra, 0); SG_LOAD(rb2, 1);
        SG_WRITE(ra, 0);
        __syncthreads();
        f32x16 c0 = {}, c1 = {};
#pragma unroll 1
        for (int kc = 0; kc < nc; kc += 2) {
            if (kc + 2 < nc) SG_LOAD(ra, kc + 2);
            SG_COMP(0);
            if (kc + 1 < nc) SG_WRITE(rb2, 1);
            __syncthreads();
            if (kc + 1 >= nc) break;
            if (kc + 3 < nc) SG_LOAD(rb2, kc + 3);
            SG_COMP(1);
            if (kc + 2 < nc) SG_WRITE(ra, 0);
            __syncthreads();
        }
#undef SG_LOAD
#undef SG_WRITE
#undef SG_COMP
#pragma unroll
        for (int r = 0; r < 16; ++r) { part[crow(r, hi) * 64 + r32] = c0[r]; part[crow(r, hi) * 64 + 32 + r32] = c1[r]; }
        __syncthreads();
        const int lr = tid >> 4, c4 = (tid & 15) * 4; f32x4 s = {0.f, 0.f, 0.f, 0.f};
#pragma unroll
        for (int w = 0; w < 8; ++w) s = s + *(const LAS f32x4*)((LAS float*)lds + w * 2048 + lr * 64 + c4);
        E(s, row0 + lr, col0 + c4, cb, lr, tid, rl);
        __syncthreads();
    }
}

constexpr int NPHASE = 15;
template <class Epi, bool STRIP = false> DI void run_gemm(LAS unsigned char* lds, const int tid, const int bid, int M, const bf16_t* A, const bf16_t* Bt, int N, int K, const float* ssp, const Epi& E, int pst = MROWS) {
    pg8::Gemm g{A, Bt, M, N, K}; pg8::Order S; S.init(M, N, GRID, bid); S.ssp = ssp; S.pst = pst; S.rs = (LAS float*)(lds + RS_OFF); S.strip = STRIP;
    pg8::gemm_phase<Epi, pg8::Order, true, true, STRIP>(lds, g, S, E, tid);
}

__global__ void __launch_bounds__(512, 2) mk_fwd(Args args) {
    extern __shared__ __attribute__((aligned(16))) unsigned char lds_raw[];
    LAS unsigned char* lds0 = (LAS unsigned char*)lds_raw;
    constexpr int NGW = GRID * 8;
    unsigned* ctl = (unsigned*)(args.ws + WS_CTL);
    volatile LAS unsigned* MISC = (volatile LAS unsigned*)(lds0 + MISC_OFF);
    for (int u = threadIdx.x; u < 256; u += 512) ((LAS unsigned*)(lds0 + MISC_OFF))[u] = 0u;
    __syncthreads();
    XcdBarrier bar; bar.bar = ctl + CW_BAR; bar.x = 0; bar.st = nullptr;
    if (!MK_PER_PHASE) bar = xcd_barrier_post(ctl + CW_BAR, MISC + 8);
    const int lo = args.ph_lo, hi = args.ph_hi;
#if defined(REP_PH)
    int rep_left = 1;
#endif
#pragma unroll 1
    for (int ph = lo; ph < hi; ++ph) {
        int tid = threadIdx.x; asm volatile("" : "+v"(tid));
        const int lane = tid & 63, wave = __builtin_amdgcn_readfirstlane(tid >> 6);
        LAS unsigned char* lds = lds0; asm volatile("" : "+s"(lds));
        int bid = blockIdx.x; asm volatile("" : "+s"(bid)); const int gw = bid * 8 + wave;
        bar.st = (volatile LAS unsigned*)(lds + MISC_OFF) + 8;
        KA ka; ka.kp = (const CAS char*)__builtin_amdgcn_kernarg_segment_ptr(); asm volatile("" : "+s"(ka.kp));
        unsigned char* ws = ka.ws(); float* X = ka.out(); bf16_t* XB = (bf16_t*)(ws + WS_XB); bf16_t* ACT = (bf16_t*)(ws + WS_ACT);
        if (ph == 0 && (PHM & 1)) prologue(ka, lds, gw, NGW, wave, lane);
        else if ((ph == 1 || ph == 6 || ph == 8 || ph == 13) && (PHM & 2)) {
            const int lh = ph == 1 ? 0 : ph == 6 ? 1 : ph == 8 ? 2 : 3, si = ph == 1 ? 0 : ph == 6 ? 2 : ph == 8 ? 3 : 6;
            run_gemm(lds, tid, bid, MROWS, XB, (const bf16_t*)(ws + WS_WGU + (size_t)lh * SZ_WGU), NGU, DM, (const float*)(ws + WS_SSP + (size_t)si * SZ_SSP), EpiSwiGLU{ACT}, ph == 1 ? 0 : MROWS);
            if ((ph == 1 || ph == 6) && bid >= 172) convert_set(ka, lds, ph == 1 ? 1 : 3, (bid - 172) * 8 + wave, 84 * 8, wave, lane);
            if (ph == 8 && bid >= 172) state_copies(ka, (bid - 172) * 512 + tid, 84 * 512);
        } else if ((ph == 2 || ph == 7 || ph == 9 || ph == 14 || ph == 5 || ph == 12) && (PHM & 4)) {
            const bool isd = !(ph == 5 || ph == 12);
            const int lh = ph == 2 ? 0 : ph == 7 ? 1 : ph == 9 ? 2 : 3;
            const int so = ph == 2 ? 1 : ph == 5 ? 2 : ph == 7 ? 3 : ph == 9 ? 4 : ph == 12 ? 6 : 7;
            const bf16_t* A = isd ? ACT : (ph == 5 ? (const bf16_t*)(ws + WS_CAT) : (const bf16_t*)(ws + WS_U));
            const bf16_t* Bt = isd ? (const bf16_t*)(ws + WS_WD + (size_t)lh * SZ_WD) : (ph == 5 ? (const bf16_t*)(ws + WS_WOUT0) : (const bf16_t*)(ws + WS_WOUT1));
            const float* ilo = nullptr; const float* ihi = nullptr;
            float* sspo = (float*)(ws + WS_SSP + (size_t)so * SZ_SSP);
            const bool fin = ph == 14; float* fx = (float*)(ws + WS_SSP + 7 * SZ_SSP); unsigned* fc = (unsigned*)(ws + WS_CTL) + CW_FIN;
            if (fin) run_gemm<EpiFinal, true>(lds, tid, bid, MP, A, Bt, DM, FF, nullptr, EpiFinal{XB, 0.5f, X, ka.in(7), fx, fc});
            else run_gemm<EpiResid, true>(lds, tid, bid, MP, A, Bt, DM, isd ? FF : DM, nullptr, EpiResid{ilo, ihi, XB, sspo, isd ? 0.5f : 1.0f});
        } else if (ph == 3 && (PHM & 8)) { run_gemm(lds, tid, bid, MROWS, XB, (const bf16_t*)(ws + WS_WIN0), NIN0, DM, (const float*)(ws + WS_SSP + 1 * SZ_SSP), EpiProj0{(bf16_t*)(ws + WS_Q), (bf16_t*)(ws + WS_K), (bf16_t*)(ws + WS_V), (bf16_t*)(ws + WS_UP)});
            if (bid >= 74) convert_set(ka, lds, 2, (bid - 74) * 8 + wave, 182 * 8, wave, lane); }
        else if (ph == 4 && (PHM & 16)) mix0_phase(ka, lds, tid, bid, gw, NGW, wave, lane);
        else if (ph == 10 && (PHM & 32)) { const float* sspi = (const float*)(ws + WS_SSP + 4 * SZ_SSP); float* sspo = (float*)(ws + WS_SSP + 5 * SZ_SSP);
            run_gemm<EpiGeluUV, true>(lds, tid, bid, MP, XB, (const bf16_t*)(ws + WS_WIN1), NIN1, DM, sspi, EpiGeluUV{(bf16_t*)(ws + WS_U), (bf16_t*)(ws + WS_V1), sspo}); }
        else if (ph == 11 && (PHM & 64)) sgu_phase(ka, lds, tid, bid, gw, NGW, wave, lane);
        else if (ph == 15 && (PHM & 128)) final_phase(ka, gw, NGW, lane);
#if defined(REP_PH)
        if (ph == REP_PH && rep_left > 0) { --rep_left; --ph; xcd_barrier(bar); continue; }
#endif
        if (ph + 1 < hi) xcd_barrier(bar);
    }
}

extern "C" void kernel_launch(void* const* d_in, const int* in_sizes, int n_in, void* d_out, int out_size, void* d_ws, size_t ws_size, hipStream_t stream) {
    static int grid = 0;
    if (grid == 0) {
        if (n_in != 21 || (size_t)out_size != O_END || ws_size < WS_END) { fprintf(stderr, "kernel_launch: unexpected shapes (n_in %d out %d ws %zu)\n", n_in, out_size, ws_size); grid = -1; return; }
        int dev = 0, cus = 0, per_cu = 0;
        if (hipGetDevice(&dev) != hipSuccess || hipDeviceGetAttribute(&cus, hipDeviceAttributeMultiprocessorCount, dev) != hipSuccess) { grid = -1; return; }
        if (hipFuncSetAttribute((const void*)mk_fwd, hipFuncAttributeMaxDynamicSharedMemorySize, LDS_BYTES) != hipSuccess) { fprintf(stderr, "kernel_launch: hipFuncSetAttribute failed\n"); grid = -1; return; }
        if (hipOccupancyMaxActiveBlocksPerMultiprocessor(&per_cu, (const void*)mk_fwd, 512, LDS_BYTES) != hipSuccess || per_cu < 1) { fprintf(stderr, "kernel_launch: occupancy query reports %d\n", per_cu); }
        (void)hipGetLastError();
        if (cus < GRID) fprintf(stderr, "kernel_launch: %d CUs < %d: the grid cannot be resident\n", cus, GRID);
        grid = GRID;
    }
    if (grid < 0) return;
    (void)hipMemsetAsync((char*)d_ws + WS_CTL + (size_t)CW_BAR * 4, 0, (size_t)(CW_FIN + 96 * 64 - CW_BAR) * 4, stream);
    Args a{};
    for (int i = 0; i < 21; ++i) a.in[i] = (const float*)d_in[i];
    a.out = (float*)d_out; a.ws = (unsigned char*)d_ws;
#if MK_PER_PHASE
    for (int p = 0; p < NPHASE; ++p) { a.ph_lo = p; a.ph_hi = p + 1; hipLaunchKernelGGL(mk_fwd, dim3(grid), dim3(512), LDS_BYTES, stream, a); }
#else
    a.ph_lo = 0; a.ph_hi = NPHASE;
    hipLaunchKernelGGL(mk_fwd, dim3(grid), dim3(512), LDS_BYTES, stream, a);
#endif
}
```
